# Optimizing an MI355X kernel written in HIP

```python
import math
import jax, jax.numpy as jnp
from jax import lax
import numpy as np

D_MODEL = 1024
BATCH = 8
SEQ = 8192
DEPTH = 4

MIX_WIDTH = D_MODEL
GROUP_WIDTH = MIX_WIDTH // 4
DA_HEADS = 4
DA_QK_DIM = 32
DA_V_DIM = GROUP_WIDTH // DA_HEADS
Q_BLOCK = 128
GLA_HEADS = 4
GLA_K_DIM = 32
GLA_V_DIM = GROUP_WIDTH // GLA_HEADS
GLA_GATE_RANK = 16
GLA_GATE_NORMALIZER = 16.0
GLA_CHUNK = 64
HG_HEADS = 4
HG_K_DIM = 64
HG_V_DIM = GROUP_WIDTH // HG_HEADS
HG_CHUNK = 64
RW_HEADS = 4
RW_HEAD = GROUP_WIDTH // RW_HEADS
RW_DECAY_RANK = 32
RW_AAA_RANK = 32
RW_GATE_RANK = 64
RW_DECAY_SCALE = 0.606531
RW_LN_EPS = 64e-5
D_FF = 4 * D_MODEL
RMS_EPS = 1e-6
MASK_VALUE = -1e30
TINY = 1e-30

A_IN = 3 * GROUP_WIDTH
B_IN = 2 * GLA_HEADS * GLA_K_DIM + GROUP_WIDTH + GLA_GATE_RANK + GROUP_WIDTH
C_IN = HG_HEADS * HG_K_DIM * 2 + GROUP_WIDTH * 2
D_IN = 3 * GROUP_WIDTH + RW_DECAY_RANK + RW_AAA_RANK + RW_GATE_RANK
P_IN = A_IN + B_IN + C_IN + D_IN

kernel_name = "hybrid_parallel_head_group_decoder"


def split_cols(p, sizes):
    idx = [int(s) for s in np.cumsum(sizes)[:-1]]
    return jnp.split(p, idx, axis=-1)


def rms_norm(x, g, eps=RMS_EPS):
    xf = x.astype(jnp.float32)
    y = xf * lax.rsqrt(jnp.mean(xf * xf, axis=-1, keepdims=True) + eps)
    return (y * g.astype(jnp.float32)).astype(x.dtype)


def alibi_slopes(n):
    return 2.0 ** (-8.0 * jnp.arange(1, n + 1, dtype=jnp.float32) / n)


def diff_attention(p, q_norm_g, k_norm_g, lq1, lk1, lq2, lk2, out_norm_g, lam_init):
    B, S, _ = p.shape
    q, k, v = split_cols(p, (GROUP_WIDTH, GROUP_WIDTH, GROUP_WIDTH))
    q = rms_norm(q.reshape(B, S, DA_HEADS, 2, DA_QK_DIM), q_norm_g) * (DA_QK_DIM ** -0.5)
    k = rms_norm(k.reshape(B, S, DA_HEADS, 2, DA_QK_DIM), k_norm_g)
    v = v.reshape(B, S, DA_HEADS, DA_V_DIM).transpose(0, 2, 1, 3)
    lam = (jnp.exp(jnp.sum(lq1 * lk1)) - jnp.exp(jnp.sum(lq2 * lk2)) + lam_init).astype(jnp.float32)
    n_blk = S // Q_BLOCK
    qb = q.reshape(B, n_blk, Q_BLOCK, DA_HEADS, 2, DA_QK_DIM).transpose(1, 0, 3, 4, 2, 5)
    kt = k.transpose(0, 2, 3, 1, 4)
    slopes = alibi_slopes(DA_HEADS)
    k_pos = jnp.arange(S)

    def attend_block(args):
        blk, q_blk = args
        q_pos = blk * Q_BLOCK + jnp.arange(Q_BLOCK)
        dist = (q_pos[:, None] - k_pos[None, :]).astype(jnp.float32)
        bias = jnp.where(dist[None] >= 0, -slopes[:, None, None] * dist[None], MASK_VALUE)
        s = jnp.einsum('bhcqd,bhckd->bhcqk', q_blk, kt).astype(jnp.float32) + bias[None, :, None]
        prob = jax.nn.softmax(s, axis=-1)
        weights = prob[:, :, 0] - lam * prob[:, :, 1]
        return jnp.einsum('bhqk,bhkv->bhqv', weights.astype(v.dtype), v)

    o = lax.map(attend_block, (jnp.arange(n_blk), qb))
    o = o.transpose(1, 0, 3, 2, 4).reshape(B, S, DA_HEADS, DA_V_DIM)
    o = rms_norm(o, out_norm_g) * (1.0 - lam_init)
    return o.reshape(B, S, GROUP_WIDTH)


def chunk_gla(q, k, v, log_f, chunk):
    B, H, T, K = q.shape
    V = v.shape[-1]
    n = T // chunk

    def to_chunks(z):
        return z.astype(jnp.float32).reshape(B, H, n, chunk, z.shape[-1]).transpose(2, 0, 1, 3, 4)

    qc, kc, vc = to_chunks(q), to_chunks(k), to_chunks(v)
    bc = jnp.cumsum(to_chunks(log_f), axis=-2)
    causal = jnp.tril(jnp.ones((chunk, chunk), dtype=bool))[:, :, None]

    def step(state, inp):
        q_i, k_i, v_i, b_i = inp
        o_inter = jnp.einsum('bhck,bhkv->bhcv', q_i * jnp.exp(b_i), state)
        rel = b_i[:, :, :, None, :] - b_i[:, :, None, :, :]
        decay = jnp.exp(jnp.where(causal, rel, MASK_VALUE))
        scores = jnp.einsum('bhik,bhijk->bhij', q_i, decay * k_i[:, :, None, :, :])
        o_intra = jnp.einsum('bhij,bhjv->bhiv', scores, v_i)
        b_last = b_i[:, :, -1:, :]
        state = jnp.exp(b_last[:, :, 0, :, None]) * state + jnp.einsum(
            'bhck,bhcv->bhkv', k_i * jnp.exp(b_last - b_i), v_i)
        return state, o_inter + o_intra

    state0 = jnp.zeros((B, H, K, V), jnp.float32)
    _, o = lax.scan(step, state0, (qc, kc, vc, bc))
    return o.transpose(1, 2, 0, 3, 4).reshape(B, H, T, V)


def gla_mixer(p, gate_up, gate_b, out_norm_g):
    B, S, _ = p.shape
    qk = GLA_HEADS * GLA_K_DIM
    q, k, v, gd, og = split_cols(p, (qk, qk, GROUP_WIDTH, GLA_GATE_RANK, GROUP_WIDTH))
    heads = lambda z, d: z.reshape(B, S, -1, d).transpose(0, 2, 1, 3)
    log_a = jax.nn.log_sigmoid((gd @ gate_up + gate_b).astype(jnp.float32)) / GLA_GATE_NORMALIZER
    o = chunk_gla(heads(q, GLA_K_DIM) * (GLA_K_DIM ** -0.5), heads(k, GLA_K_DIM),
                  heads(v, GLA_V_DIM), heads(log_a, GLA_K_DIM), GLA_CHUNK)
    o = o.transpose(0, 2, 1, 3).astype(p.dtype)
    return rms_norm(o, out_norm_g).reshape(B, S, GROUP_WIDTH) * jax.nn.silu(og)


def hgrn2_mixer(p, lower_bound, out_norm_g):
    B, S, _ = p.shape
    fk = HG_HEADS * HG_K_DIM
    q, f, i, og = split_cols(p, (fk, fk, GROUP_WIDTH, GROUP_WIDTH))
    lb = lower_bound.astype(jnp.float32)
    z = f.astype(jnp.float32)
    forget = lb + (1.0 - lb) * jax.nn.sigmoid(z)
    log_f = jnp.log(jnp.maximum(forget, TINY))
    k = (1.0 - lb) * jax.nn.sigmoid(-z)
    heads = lambda t, d: t.reshape(B, S, -1, d).transpose(0, 2, 1, 3)
    o = chunk_gla(heads(jax.nn.silu(q), HG_K_DIM), heads(k, HG_K_DIM),
                  heads(i, HG_V_DIM), heads(log_f, HG_K_DIM), HG_CHUNK)
    o = o.transpose(0, 2, 1, 3).astype(p.dtype)
    return rms_norm(o, out_norm_g).reshape(B, S, GROUP_WIDTH) * jax.nn.silu(og)


def rwkv7_recurrence(r, w, k, v, kk, a):
    B, S, H, N = r.shape
    tm = lambda z: z.astype(jnp.float32).transpose(1, 0, 2, 3)

    def step(state, inp):
        r_t, w_t, k_t, v_t, kk_t, a_t = inp
        sa = jnp.einsum('bhvk,bhk->bhv', state, -kk_t)
        state = (state * w_t[:, :, None, :] + sa[..., None] * (kk_t * a_t)[:, :, None, :]
                 + v_t[..., None] * k_t[:, :, None, :])
        return state, jnp.einsum('bhvk,bhk->bhv', state, r_t)

    state0 = jnp.zeros((B, H, N, N), jnp.float32)
    _, y = lax.scan(step, state0, (tm(r), tm(w), tm(k), tm(v), tm(kk), tm(a)))
    return y.transpose(1, 0, 2, 3)


def rwkv7_mixer(p, shift_mu, w0, w_up, a0, a_up, g_up, k_k, k_a, r_k, ln_g, ln_b):
    B, S, _ = p.shape
    prev = jnp.pad(p, ((0, 0), (1, 0), (0, 0)))[:, :-1]
    p = p + shift_mu * (prev - p)
    r, k, v, wd, ad, gd = split_cols(p, (GROUP_WIDTH, GROUP_WIDTH, GROUP_WIDTH,
                                         RW_DECAY_RANK, RW_AAA_RANK, RW_GATE_RANK))
    log_w = -RW_DECAY_SCALE * jax.nn.sigmoid(w0 + jnp.tanh(wd) @ w_up)
    a = jax.nn.sigmoid(a0 + ad @ a_up)
    g = jax.nn.sigmoid(gd) @ g_up
    heads = lambda z: z.reshape(B, S, RW_HEADS, RW_HEAD)
    kk = heads(k * k_k).astype(jnp.float32)
    kk = kk * lax.rsqrt(jnp.maximum(jnp.sum(kk * kk, axis=-1, keepdims=True), 1e-24))
    k = k * (1.0 + (a - 1.0) * k_a)
    y = rwkv7_recurrence(heads(r), jnp.exp(heads(log_w).astype(jnp.float32)), heads(k), heads(v), kk, heads(a))
    mu = jnp.mean(y, axis=-1, keepdims=True)
    var = jnp.mean(jnp.square(y - mu), axis=-1, keepdims=True)
    yn = ((y - mu) * lax.rsqrt(var + RW_LN_EPS)).reshape(B, S, GROUP_WIDTH)
    yn = yn * ln_g.astype(jnp.float32) + ln_b.astype(jnp.float32)
    bonus = jnp.sum(heads(r) * heads(k) * r_k, axis=-1, keepdims=True) * heads(v)
    out = (yn + bonus.reshape(B, S, GROUP_WIDTH).astype(jnp.float32)) * g.astype(jnp.float32)
    return out.astype(p.dtype)


def setup_inputs(seed: int = 0) -> dict:
    key = jax.random.key(seed)
    ks = list(jax.random.split(key, 32))
    nrm = lambda shape, scale: scale * jax.random.normal(ks.pop(), shape, jnp.float32)
    gain = lambda shape: 1.0 + nrm(shape, 0.02)
    L = DEPTH
    return {
        "x": nrm((BATCH, SEQ, D_MODEL), 1.0),
        "norm_mix_g": gain((L, D_MODEL)),
        "w_in": nrm((L, D_MODEL, P_IN), D_MODEL ** -0.5),
        "da_q_norm_g": gain((L, DA_QK_DIM)),
        "da_k_norm_g": gain((L, DA_QK_DIM)),
        "da_lambda_q1": nrm((L, DA_QK_DIM), 0.1),
        "da_lambda_k1": nrm((L, DA_QK_DIM), 0.1),
        "da_lambda_q2": nrm((L, DA_QK_DIM), 0.1),
        "da_lambda_k2": nrm((L, DA_QK_DIM), 0.1),
        "da_out_norm_g": gain((L, DA_V_DIM)),
        "gla_gate_up": nrm((L, GLA_GATE_RANK, GLA_HEADS * GLA_K_DIM), GLA_GATE_RANK ** -0.5),
        "gla_gate_b": nrm((L, GLA_HEADS * GLA_K_DIM), 0.1),
        "gla_out_norm_g": gain((L, GLA_V_DIM)),
        "hgrn_lb_logits": nrm((L, HG_HEADS * HG_K_DIM), 0.5),
        "hgrn_out_norm_g": gain((L, HG_V_DIM)),
        "rw_shift_mu": jax.random.uniform(ks.pop(), (L, D_IN), jnp.float32, 0.0, 1.0),
        "rw_w0": -0.5 + nrm((L, GROUP_WIDTH), 0.5),
        "rw_w_up": nrm((L, RW_DECAY_RANK, GROUP_WIDTH), 0.5 * RW_DECAY_RANK ** -0.5),
        "rw_a0": nrm((L, GROUP_WIDTH), 0.1),
        "rw_a_up": nrm((L, RW_AAA_RANK, GROUP_WIDTH), 0.5 * RW_AAA_RANK ** -0.5),
        "rw_g_up": nrm((L, RW_GATE_RANK, GROUP_WIDTH), RW_GATE_RANK ** -0.5),
        "rw_k_k": 0.85 + nrm((L, GROUP_WIDTH), 0.05),
        "rw_k_a": 1.0 + nrm((L, GROUP_WIDTH), 0.05),
        "rw_r_k": nrm((L, RW_HEADS, RW_HEAD), 0.1),
        "rw_ln_g": gain((L, GROUP_WIDTH)),
        "rw_ln_b": nrm((L, GROUP_WIDTH), 0.02),
        "w_out": nrm((L, MIX_WIDTH, D_MODEL), MIX_WIDTH ** -0.5),
        "norm_mlp_g": gain((L, D_MODEL)),
        "w_mlp_up": nrm((L, D_MODEL, D_FF), D_MODEL ** -0.5),
        "w_mlp_down": nrm((L, D_FF, D_MODEL), D_FF ** -0.5),
    }


def reference(x, norm_mix_g, w_in, da_q_norm_g, da_k_norm_g, da_lambda_q1, da_lambda_k1,
              da_lambda_q2, da_lambda_k2, da_out_norm_g, gla_gate_up, gla_gate_b, gla_out_norm_g,
              hgrn_lb_logits, hgrn_out_norm_g, rw_shift_mu, rw_w0, rw_w_up, rw_a0, rw_a_up, rw_g_up,
              rw_k_k, rw_k_a, rw_r_k, rw_ln_g, rw_ln_b, w_out, norm_mlp_g, w_mlp_up, w_mlp_down):
    probs = jax.nn.softmax(hgrn_lb_logits.astype(jnp.float32), axis=0)
    lower_bounds = jnp.cumsum(probs, axis=0) - probs[0]
    for l in range(DEPTH):
        lam_init = 0.8 - 0.6 * math.exp(-0.3 * l)
        h = rms_norm(x, norm_mix_g[l])
        proj = h @ w_in[l]
        pa, pb, pc, pd = split_cols(proj, (A_IN, B_IN, C_IN, D_IN))
        o_a = diff_attention(pa, da_q_norm_g[l], da_k_norm_g[l], da_lambda_q1[l], da_lambda_k1[l],
                             da_lambda_q2[l], da_lambda_k2[l], da_out_norm_g[l], lam_init)
        o_b = gla_mixer(pb, gla_gate_up[l], gla_gate_b[l], gla_out_norm_g[l])
        o_c = hgrn2_mixer(pc, lower_bounds[l], hgrn_out_norm_g[l])
        o_d = rwkv7_mixer(pd, rw_shift_mu[l], rw_w0[l], rw_w_up[l], rw_a0[l], rw_a_up[l], rw_g_up[l],
                          rw_k_k[l], rw_k_a[l], rw_r_k[l], rw_ln_g[l], rw_ln_b[l])
        mixed = jnp.concatenate([o_a, o_b.astype(x.dtype), o_c.astype(x.dtype), o_d], axis=-1)
        x = x + mixed @ w_out[l]
        h = rms_norm(x, norm_mlp_g[l])
        x = x + jnp.square(jax.nn.relu(h @ w_mlp_up[l])) @ w_mlp_down[l]
    return x
```

```cpp
#include <hip/hip_runtime.h>
#include <cstdio>
#include <cstdint>
#include <cmath>
namespace pg8 {
#define PG8_LAS __attribute__((address_space(3)))
typedef unsigned short bf16_t;
typedef short bf16x8 __attribute__((ext_vector_type(8)));
typedef float f32x4 __attribute__((ext_vector_type(4)));
typedef unsigned u32x4 __attribute__((ext_vector_type(4)));
constexpr int BM = 256, BK = 64, HALF = 128, HTB = HALF * BK * 2  , STAGE_BYTES = 8 * HTB, NXCD = 8, WGM = 8;

__host__ __device__ __forceinline__ int lds_byte(int r, int c) { const int st = (r >> 4) * 2 + (c >> 5), rr = r & 15, cc = c & 31, ob = rr * 64 + cc * 2; return st * 1024 + (ob ^ (((ob >> 9) & 1) << 5)); }
__host__ __device__ __forceinline__ void stage_rc(int b, int& R, int& C) { const int st = b / 1024, sb = b % 1024, swz = sb ^ (((sb >> 9) & 1) << 5); R = (st >> 1) * 16 + swz / 64; C = (st & 1) * 32 + (swz % 64) / 2; }
__host__ __device__ __forceinline__ int perm32(int rho) { const int n = rho >> 4, i = rho & 15; return 8 * (i >> 2) + 4 * n + (i & 3); }

struct Unit { int pm, pn; };
struct Gemm { const bf16_t* A; const bf16_t* Bt; int M, N, K, lda; };

struct StaticOrder {
    int nM, nN, nwg, G, c;
    __host__ __device__ void init(int M, int N, int G_, int c_) { nM = M / BM; nN = N / BM; nwg = nM * nN; G = G_; c = c_; }
    __host__ __device__ bool next(int i, Unit& u) const {
        const long L = (long)i * G + c; if (L >= nwg) return false;
        int wgid = (int)L; { const int q = nwg / NXCD, r = nwg % NXCD, xcd = wgid % NXCD, off = wgid / NXCD; wgid = (xcd < r ? xcd * (q + 1) : r * (q + 1) + (xcd - r) * q) + off; }
        const int nig = WGM * nN, gid = wgid / nig, fm = gid * WGM, gsz = (nM - fm) < WGM ? (nM - fm) : WGM;
        u.pm = fm + ((wgid % nig) % gsz); u.pn = (wgid % nig) / gsz; return true;
    }
    __device__ __forceinline__ void a_ready(const Unit&) const {}
    __device__ __forceinline__ void done(const Unit&) const {}
};

__device__ __forceinline__ unsigned cvt_pk_bf16(float lo, float hi) { unsigned r; asm volatile("v_cvt_pk_bf16_f32 %0, %1, %2" : "=v"(r) : "v"(lo), "v"(hi)); return r; }
typedef float f32x2 __attribute__((ext_vector_type(2)));
template <int ACT  > struct EpiStoreBf16 {
    static constexpr bool PERM = true, AFTER_DRAIN = false;
    bf16_t* O; int ldc;
    __device__ __forceinline__ void operator()(const f32x4 (&acc)[2][2][4][2], const Unit& u, int wr, int wc, int fr, int fq) const {
        const int row0 = u.pm * BM + wr * 64 + fr, col0 = u.pn * BM + wc * 32 + 8 * fq;
#pragma unroll
        for (int ai = 0; ai < 2; ++ai)
#pragma unroll
            for (int m = 0; m < 4; ++m) { bf16_t* rowp = O + (size_t)(row0 + ai * HALF + m * 16) * ldc + col0;
#pragma unroll
                for (int bj = 0; bj < 2; ++bj) { f32x4 v0 = acc[ai][bj][m][0], v1 = acc[ai][bj][m][1];
                    if (ACT == 1) { const f32x4 z = {0.f, 0.f, 0.f, 0.f}; v0 = __builtin_elementwise_max(v0, z); v1 = __builtin_elementwise_max(v1, z); v0 = v0 * v0; v1 = v1 * v1; }
                    u32x4 w; w.x = cvt_pk_bf16(v0[0], v0[1]); w.y = cvt_pk_bf16(v0[2], v0[3]); w.z = cvt_pk_bf16(v1[0], v1[1]); w.w = cvt_pk_bf16(v1[2], v1[3]);
                    *(u32x4*)(rowp + bj * HALF) = w; } }
    }
};
struct EpiResid {
    static constexpr bool PERM = true, AFTER_DRAIN = false;
    const float* R; float* O; int ldc;
    __device__ __forceinline__ void operator()(const f32x4 (&acc)[2][2][4][2], const Unit& u, int wr, int wc, int fr, int fq) const {
        const int row0 = u.pm * BM + wr * 64 + fr, col0 = u.pn * BM + wc * 32 + 8 * fq;
#pragma unroll
        for (int ai = 0; ai < 2; ++ai)
#pragma unroll
            for (int m = 0; m < 4; ++m) { const size_t off = (size_t)(row0 + ai * HALF + m * 16) * ldc + col0;
#pragma unroll
                for (int bj = 0; bj < 2; ++bj) { const f32x4 r0 = *(const f32x4*)(R + off + bj * HALF), r1 = *(const f32x4*)(R + off + bj * HALF + 4);
                    *(f32x4*)(O + off + bj * HALF) = r0 + acc[ai][bj][m][0]; *(f32x4*)(O + off + bj * HALF + 4) = r1 + acc[ai][bj][m][1]; } }
    }
};
template <class Epi, class Sched, bool ALIGN_EPI = false, bool SP2 = false>
__device__ __forceinline__ void gemm_phase(PG8_LAS unsigned char* lds, const Gemm g, const Sched& S, const Epi& E) {
    int tid_ = threadIdx.x; asm volatile("" : "+v"(tid_));
    const int tid = tid_, wid = __builtin_amdgcn_readfirstlane(tid >> 6), lane = tid & 63, wr = wid >> 2, wc = wid & 3, fr = lane & 15, fq = lane >> 4;
    const int K = g.K, nt = K / BK;
    unsigned voffA[2], voffB[2];
#pragma unroll
    for (int i = 0; i < 2; ++i) { int R, C; stage_rc(tid * 16 + i * 8192, R, C); const int Rb = Epi::PERM ? ((R & ~31) + perm32(R & 31)) : R;
        voffA[i] = (unsigned)(R * g.lda + C) * 2u; voffB[i] = (unsigned)(Rb * K + C) * 2u; }
    const size_t kstep = (size_t)(BK * 2);
    const size_t hstep = (size_t)HALF * K * 2;
    const size_t tstep = 2 * hstep; const size_t hstepA = (size_t)HALF * g.lda * 2, tstepA = 2 * hstepA;
    const unsigned ldsw = (unsigned)wid * 1024u;
    const int aoff = lds_byte(wr * 64 + fr, fq * 8), boff = lds_byte(wc * 32 + fr, fq * 8);
#define PG8_SA(b, h) (((b) * 2 + (h)) * HTB)
#define PG8_SB(b, h) ((4 + (b) * 2 + (h)) * HTB)
#define PG8_STAGE(bufoff, gbase, voff) do { _Pragma("unroll") for (int _i = 0; _i < 2; ++_i) \
        __builtin_amdgcn_global_load_lds((const unsigned*)((const char*)(gbase) + (voff)[_i]), (PG8_LAS unsigned*)(lds + (bufoff) + ldsw + _i * 8192), 16, 0, 0); } while (0)
#define PG8_LDA(dst, b, h) do { _Pragma("unroll") for (int m = 0; m < 4; ++m) _Pragma("unroll") for (int k = 0; k < 2; ++k) dst[m][k] = *(const PG8_LAS bf16x8*)(lds + PG8_SA(b, h) + aoff + m * 2048 + k * 1024); } while (0)
#define PG8_LDB(dst, b, h) do { _Pragma("unroll") for (int n = 0; n < 2; ++n) _Pragma("unroll") for (int k = 0; k < 2; ++k) dst[n][k] = *(const PG8_LAS bf16x8*)(lds + PG8_SB(b, h) + boff + n * 2048 + k * 1024); } while (0)
#define PG8_MMA(ai, bj, At, Bt) do { __builtin_amdgcn_s_setprio(1); _Pragma("unroll") for (int m = 0; m < 4; ++m) _Pragma("unroll") for (int n = 0; n < 2; ++n) _Pragma("unroll") for (int k = 0; k < 2; ++k) \
        acc[ai][bj][m][n] = __builtin_amdgcn_mfma_f32_16x16x32_bf16(Bt[n][k], At[m][k], acc[ai][bj][m][n], 0, 0, 0); __builtin_amdgcn_s_setprio(0); } while (0)
#define PG8_WAIT_V(n) asm volatile("s_waitcnt vmcnt(" #n ")" ::: "memory")
#define PG8_WAIT_L(n) asm volatile("s_waitcnt lgkmcnt(" #n ")" ::: "memory")
#define PG8_BAR __builtin_amdgcn_s_barrier()
#define PG8_SCHED __builtin_amdgcn_sched_barrier(0)
    Unit cur, nxt; int ui = 0;
    if (!S.next(0, cur)) return;
    f32x4 acc[2][2][4][2];
#pragma unroll
    for (int a = 0; a < 2; ++a)
#pragma unroll
        for (int b = 0; b < 2; ++b)
#pragma unroll
            for (int m = 0; m < 4; ++m)
#pragma unroll
                for (int n = 0; n < 2; ++n) acc[a][b][m][n] = (f32x4){0.f, 0.f, 0.f, 0.f};
    bf16x8 At[4][2], B0[2][2], B1[2][2];
    const char* cA = (const char*)g.A + (size_t)cur.pm * tstepA; const char* cB = (const char*)g.Bt + (size_t)cur.pn * tstep;
    S.a_ready(cur);
    if constexpr (SP2) {
        PG8_STAGE(PG8_SB(0, 0), cB, voffB); PG8_STAGE(PG8_SB(0, 1), cB + hstep, voffB); PG8_STAGE(PG8_SA(0, 0), cA, voffA); PG8_STAGE(PG8_SA(0, 1), cA + hstepA, voffA);
        if (wr == 1) PG8_BAR;
        PG8_WAIT_V(2); PG8_BAR;
        PG8_STAGE(PG8_SB(1, 0), cB + kstep, voffB); PG8_STAGE(PG8_SA(1, 0), cA + kstep, voffA); PG8_STAGE(PG8_SB(1, 1), cB + hstep + kstep, voffB);
        PG8_WAIT_V(6); PG8_BAR;
    } else {
        PG8_STAGE(PG8_SB(0, 0), cB, voffB); PG8_STAGE(PG8_SA(0, 0), cA, voffA); PG8_STAGE(PG8_SB(0, 1), cB + hstep, voffB); PG8_STAGE(PG8_SA(0, 1), cA + hstepA, voffA);
        if (wr == 1) PG8_BAR;
        PG8_WAIT_V(4); PG8_BAR;
        PG8_STAGE(PG8_SB(1, 0), cB + kstep, voffB); PG8_STAGE(PG8_SA(1, 0), cA + kstep, voffA); PG8_STAGE(PG8_SB(1, 1), cB + hstep + kstep, voffB);
        PG8_WAIT_V(6); PG8_BAR;
    }
    for (;;) {
        const bool has_next = S.next(ui + 1, nxt);
        const char* nA = has_next ? (const char*)g.A + (size_t)nxt.pm * tstepA : cA; const char* nB = has_next ? (const char*)g.Bt + (size_t)nxt.pn * tstep : cB;
        for (int t = 0; t < nt; t += 2) {
            const bool last = (t == nt - 2);
            const char* a1 = cA + (size_t)(t + 1) * kstep;
            const char* a2 = last ? nA : cA + (size_t)(t + 2) * kstep; const char* b2 = last ? nB : cB + (size_t)(t + 2) * kstep;
            const char* a3 = a2 + kstep; const char* b3 = b2 + kstep;
            if (last && has_next) S.a_ready(nxt);
            if constexpr (SP2) {
            PG8_LDB(B0, 0, 0); PG8_LDB(B1, 0, 1); PG8_SCHED; PG8_LDA(At, 0, 0); PG8_STAGE(PG8_SA(1, 1), a1 + hstepA, voffA);
            PG8_WAIT_V(8); PG8_WAIT_L(0); PG8_BAR; PG8_MMA(0, 0, At, B0); PG8_MMA(0, 1, At, B1); PG8_BAR; PG8_SCHED;
            PG8_LDA(At, 0, 1); PG8_STAGE(PG8_SB(0, 0), b2, voffB); PG8_STAGE(PG8_SB(0, 1), b2 + hstep, voffB); PG8_STAGE(PG8_SA(0, 0), a2, voffA);
            PG8_WAIT_V(8); PG8_WAIT_L(0); PG8_BAR; PG8_MMA(1, 0, At, B0); PG8_MMA(1, 1, At, B1); PG8_BAR; PG8_SCHED;
            PG8_LDB(B0, 1, 0); PG8_LDB(B1, 1, 1); PG8_SCHED; PG8_LDA(At, 1, 0); PG8_STAGE(PG8_SA(0, 1), a2 + hstepA, voffA);
            PG8_WAIT_V(8); PG8_WAIT_L(0); PG8_BAR; PG8_MMA(0, 0, At, B0); PG8_MMA(0, 1, At, B1); PG8_BAR; PG8_SCHED;
            PG8_LDA(At, 1, 1); PG8_STAGE(PG8_SB(1, 0), b3, voffB); PG8_STAGE(PG8_SB(1, 1), b3 + hstep, voffB); PG8_STAGE(PG8_SA(1, 0), a3, voffA);
            PG8_WAIT_V(8); PG8_WAIT_L(0); PG8_BAR; PG8_MMA(1, 0, At, B0); PG8_MMA(1, 1, At, B1); PG8_BAR; PG8_SCHED;
            } else {
            PG8_LDB(B0, 0, 0); PG8_SCHED; PG8_LDA(At, 0, 0); PG8_STAGE(PG8_SA(1, 1), a1 + hstepA, voffA);
            PG8_WAIT_L(8); PG8_BAR; PG8_WAIT_L(0); PG8_MMA(0, 0, At, B0); PG8_BAR; PG8_SCHED;
            PG8_LDB(B1, 0, 1); PG8_STAGE(PG8_SB(0, 0), b2, voffB);
            PG8_BAR; PG8_WAIT_L(0); PG8_MMA(0, 1, At, B1); PG8_BAR;
            PG8_LDA(At, 0, 1); PG8_STAGE(PG8_SA(0, 0), a2, voffA);
            PG8_BAR; PG8_WAIT_L(0); PG8_MMA(1, 0, At, B0); PG8_BAR; PG8_SCHED;
            PG8_STAGE(PG8_SB(0, 1), b2 + hstep, voffB);
            PG8_WAIT_V(6); PG8_BAR; PG8_MMA(1, 1, At, B1); PG8_BAR;
            PG8_LDB(B0, 1, 0); PG8_SCHED; PG8_LDA(At, 1, 0); PG8_STAGE(PG8_SA(0, 1), a2 + hstepA, voffA);
            PG8_WAIT_L(8); PG8_BAR; PG8_WAIT_L(0); PG8_MMA(0, 0, At, B0); PG8_BAR; PG8_SCHED;
            PG8_LDB(B1, 1, 1); PG8_STAGE(PG8_SB(1, 0), b3, voffB);
            PG8_BAR; PG8_WAIT_L(0); PG8_MMA(0, 1, At, B1); PG8_BAR;
            PG8_LDA(At, 1, 1); PG8_STAGE(PG8_SA(1, 0), a3, voffA);
            PG8_BAR; PG8_WAIT_L(0); PG8_MMA(1, 0, At, B0); PG8_BAR; PG8_SCHED;
            PG8_STAGE(PG8_SB(1, 1), b3 + hstep, voffB);
            PG8_WAIT_V(6); PG8_BAR; PG8_MMA(1, 1, At, B1); PG8_BAR;
            }
        }
        if constexpr (ALIGN_EPI) { if (wr == 0) PG8_BAR; }
        if constexpr (!Epi::AFTER_DRAIN) { E(acc, cur, wr, wc, fr, fq); S.done(cur); }
        if (!has_next) break;
#pragma unroll
        for (int a = 0; a < 2; ++a)
#pragma unroll
            for (int b = 0; b < 2; ++b)
#pragma unroll
                for (int m = 0; m < 4; ++m)
#pragma unroll
                    for (int n = 0; n < 2; ++n) acc[a][b][m][n] = (f32x4){0.f, 0.f, 0.f, 0.f};
        cur = nxt; cA = nA; cB = nB; ++ui;
        if constexpr (ALIGN_EPI) { if (wr == 1) PG8_BAR; }
    }
    PG8_WAIT_V(0);
    if constexpr (!ALIGN_EPI) { if (wr == 0) PG8_BAR; }
    PG8_BAR;
    if constexpr (Epi::AFTER_DRAIN) { E.fused(acc, cur, wr, wc, fr, fq, lds, wid, lane); S.done(cur); }
#undef PG8_SA
#undef PG8_SB
#undef PG8_STAGE
#undef PG8_LDA
#undef PG8_LDB
#undef PG8_MMA
#undef PG8_WAIT_V
#undef PG8_WAIT_L
#undef PG8_BAR
#undef PG8_SCHED
}
}
typedef unsigned u32x4 __attribute__((ext_vector_type(4)));
#define GAS __attribute__((address_space(1)))
#define LAS __attribute__((address_space(3)))
typedef unsigned short bf16;
typedef unsigned v4u __attribute__((ext_vector_type(4)));
typedef float f32x4 __attribute__((ext_vector_type(4)));
typedef short bf16x8 __attribute__((ext_vector_type(8)));
typedef GAS unsigned gu32;
typedef GAS unsigned long long gu64;
#define RLX_AGENT __ATOMIC_RELAXED, __HIP_MEMORY_SCOPE_AGENT
#define LDS_WAIT() asm volatile("s_waitcnt lgkmcnt(0)" ::: "memory")
#define VM_WAIT() asm volatile("s_waitcnt vmcnt(0)" ::: "memory")
__device__ __forceinline__ unsigned long long rt() { return __builtin_amdgcn_s_memrealtime(); }
__device__ __forceinline__ unsigned f2bf(float f) { unsigned u = __builtin_bit_cast(unsigned, f); return (u + 0x7fffu + ((u >> 16) & 1u)) >> 16; }
__device__ __forceinline__ unsigned pk2(float lo, float hi) { return f2bf(lo) | (f2bf(hi) << 16); }

#define XB_TMO      128
#define XB_XCNT(j)  (256  + 64 * (j))
#define XB_XSUB(j)  (1280 + 64 * (j))
#define XB_XGEN(j)  (2304 + 64 * (j))
#define XB_TOP      3328
#define XB_TOPGEN   3392
#define XCD_BAR_WORDS 3456
#define XB_SPIN_CAP (1u << 20)

__device__ __forceinline__ unsigned xb_ld(unsigned* p)              { return __hip_atomic_load(p, __ATOMIC_RELAXED, __HIP_MEMORY_SCOPE_AGENT); }
__device__ __forceinline__ unsigned xb_add(unsigned* p, unsigned v) { return __hip_atomic_fetch_add(p, v, __ATOMIC_RELAXED, __HIP_MEMORY_SCOPE_AGENT); }
__device__ __forceinline__ unsigned xb_xcc_id() { return (unsigned)__builtin_amdgcn_s_getreg((3 << 11) | 20) & 0xFu; }
#define XB_SPIN(cond, bar) do { unsigned _sp = 0; while (cond) { __builtin_amdgcn_s_sleep(1); \
    if ((++_sp & 255u) == 0u) { if (xb_ld(&(bar)[XB_TMO])) break; if (_sp > XB_SPIN_CAP) { atomicAdd(&(bar)[XB_TMO], 1u); break; } } } } while (0)

struct XcdBarrier {
    unsigned* bar; unsigned x;
    volatile LAS unsigned* st;
};

__device__ __forceinline__ XcdBarrier xcd_barrier_post(unsigned* bar, volatile LAS unsigned* st) {
    XcdBarrier b; b.bar = bar; b.x = xb_xcc_id(); b.st = st;
    if (threadIdx.x == 0) (void)xb_add(&bar[XB_XCNT(b.x)], 1u);
    return b;
}
__device__ __forceinline__ void xcd_barrier_complete(unsigned* bar, unsigned x, unsigned& nloc, unsigned& nx) {
    const unsigned G = gridDim.x * gridDim.y * gridDim.z;
    unsigned sum, cnt, mine, sp = 0u;
    for (;;) {
        sum = 0u; cnt = 0u; mine = 0u;
#pragma unroll
        for (unsigned j = 0; j < 16; ++j) { const unsigned c = xb_ld(&bar[XB_XCNT(j)]); sum += c; cnt += (c > 0u) ? 1u : 0u; mine = (j == x) ? c : mine; }
        if (sum == G) break;
        __builtin_amdgcn_s_sleep(1);
        if ((++sp & 255u) == 0u) { if (xb_ld(&bar[XB_TMO])) break; if (sp > XB_SPIN_CAP) { atomicAdd(&bar[XB_TMO], 1u); break; } }
    }
    nloc = mine > 0u ? mine : 1u; nx = cnt > 0u ? cnt : 1u;
}

__device__ __forceinline__ void xcd_barrier(const XcdBarrier& b) {
    asm volatile("s_waitcnt vmcnt(0)" ::: "memory");
    __syncthreads();
    if (threadIdx.x == 0) {
        unsigned* bar = b.bar;
        __builtin_amdgcn_s_waitcnt(0);
        unsigned nloc = b.st[0], nx = b.st[1];
        if (nloc == 0u) { xcd_barrier_complete(bar, b.x, nloc, nx); b.st[0] = nloc; b.st[1] = nx; }
        const unsigned old = xb_add(&bar[XB_XSUB(b.x)], 1u);
        const unsigned gen = old / nloc;
        if (old + 1u == (gen + 1u) * nloc) {
            __builtin_amdgcn_fence(__ATOMIC_RELEASE, "agent");
            asm volatile("s_waitcnt vmcnt(0)" ::: "memory");
            const unsigned og = xb_add(&bar[XB_TOP], 1u);
            const unsigned tg = og / nx;
            if (og + 1u == (tg + 1u) * nx) xb_add(&bar[XB_TOPGEN], 1u);
            else XB_SPIN(xb_ld(&bar[XB_TOPGEN]) == tg, bar);
            __builtin_amdgcn_fence(__ATOMIC_ACQUIRE, "agent");
            xb_add(&bar[XB_XGEN(b.x)], 1u);
            asm volatile("s_waitcnt vmcnt(0)" ::: "memory");
        } else {
            XB_SPIN(xb_ld(&bar[XB_XGEN(b.x)]) == gen, bar);
            __builtin_amdgcn_fence(__ATOMIC_ACQUIRE, "agent");
            asm volatile("s_waitcnt vmcnt(0)" ::: "memory");
        }
    }
    __syncthreads();
}
constexpr int NWAVES = 8;
constexpr int BATCH = 8, SEQ = 8192, D = 1024, M = BATCH * SEQ, NL = 4, PIN = 3472, PINP = 3584, FF = 4096;
constexpr int SA0 = 0, SB0 = 768, SC0 = 1552, SD0 = 2576;
constexpr float LOG2E = 1.4426950408889634f;
constexpr size_t MiB = 1u << 20;
constexpr size_t WS_CTL = 0, CTL_ZERO_BYTES = 1 * MiB;
constexpr size_t WS_LC = 1 * MiB;
constexpr size_t WS_LB = 1 * MiB + 65536;
constexpr size_t WS_BS = 2 * MiB;
constexpr size_t WS_ZG = 4 * MiB;
constexpr size_t WS_WI = 20 * MiB, WS_WO = 48 * MiB, WS_WU = 56 * MiB, WS_WD = 88 * MiB;
constexpr size_t WS_PR = 120 * MiB;
constexpr size_t WS_SC = 568 * MiB;
constexpr size_t WS_X2 = 856 * MiB;
constexpr size_t WS_H = 120 * MiB;
constexpr size_t WS_END = 984 * MiB;
constexpr size_t SC_RWS = 0, SC_HS = 160 * MiB, SC_GS = 224 * MiB;
constexpr int CW_TMO = 0, CW_CODE = 1, CW_BAR = 4096;
constexpr int RING_OFF = 0, RING_BYTES = 131072;
constexpr int LDSCTL_OFF = RING_BYTES, MISC_OFF = LDSCTL_OFF + 320;
constexpr int LDS_BYTES = 147456;
typedef float f32x16 __attribute__((ext_vector_type(16)));
typedef short s16x4 __attribute__((ext_vector_type(4)));
struct Args { const float* in[30]; float* out; unsigned char* ws; };
struct Frame {
    LAS unsigned char* lds;
    volatile LAS unsigned* MISC;
    gu32* ctl;
    int tid, lane, wave;
    int vcu, G;
    float* out; unsigned char* ws;
    bf16* PR; bf16* X2; bf16* HB; bf16* ZG; float* LC; float* LB; float* BS;
};
__device__ __forceinline__ float bf2f(unsigned short b) { return __builtin_bit_cast(float, (unsigned)b << 16); }
__device__ __forceinline__ float wave_sum(float v) {
#pragma unroll
    for (int o = 1; o < 64; o <<= 1) v += __shfl_xor(v, o);
    return v;
}
__device__ __forceinline__ float wave_max(float v) {
#pragma unroll
    for (int o = 1; o < 64; o <<= 1) v = fmaxf(v, __shfl_xor(v, o));
    return v;
}
__device__ __forceinline__ float sigmoidf_(float x) { return 1.f / (1.f + __expf(-x)); }

__device__ __forceinline__ void p0_transpose_item(const float* W, int K, int N, int NP, bf16* WT, LAS float* scr, int item, int lane) {
    const int nblk = NP / 32, kb = item / nblk, nb = item % nblk, k0 = 64 * kb, n0 = 32 * nb;
    const int ncol = n0 + (lane & 31);
#pragma unroll 8
    for (int i = 0; i < 32; ++i) { const int kk = 2 * i + (lane >> 5); scr[kk * 33 + (lane & 31)] = (ncol < N) ? W[(size_t)(k0 + kk) * N + ncol] : 0.f; }
    LDS_WAIT(); asm volatile("" ::: "memory");
    const int c = lane & 7;
#pragma unroll
    for (int j = 0; j < 4; ++j) { const int n = (lane >> 3) + 8 * j; const LAS float* s = scr + (8 * c) * 33 + n;
        v4u o; o.x = pk2(s[0 * 33], s[1 * 33]); o.y = pk2(s[2 * 33], s[3 * 33]); o.z = pk2(s[4 * 33], s[5 * 33]); o.w = pk2(s[6 * 33], s[7 * 33]);
        *(GAS v4u*)(WT + (size_t)(n0 + n) * K + k0 + 8 * c) = o; }
    LDS_WAIT(); asm volatile("" ::: "memory");
}
__device__ __forceinline__ void p0_prologue(Frame& F, const Args& A) {
    LAS float* scr = (LAS float*)(F.lds + RING_OFF + F.wave * 16384);
    const int gw = F.vcu * NWAVES + F.wave, NGW = F.G * NWAVES;
    constexpr int I_I = (D / 64) * (PINP / 32), I_O = (D / 64) * (D / 32), I_U = (D / 64) * (FF / 32), I_D = (FF / 64) * (D / 32);
    constexpr int PER_L = I_I + I_O + I_U + I_D;
    for (int it = gw; it < NL * PER_L; it += NGW) {
        const int l = it / PER_L; int r = it % PER_L;
        if (r < I_I) { p0_transpose_item(A.in[2] + (size_t)l * D * PIN, D, PIN, PINP, (bf16*)(F.ws + WS_WI) + (size_t)l * PINP * D, scr, r, F.lane); continue; } r -= I_I;
        if (r < I_O) { p0_transpose_item(A.in[26] + (size_t)l * D * D, D, D, D, (bf16*)(F.ws + WS_WO) + (size_t)l * D * D, scr, r, F.lane); continue; } r -= I_O;
        if (r < I_U) { p0_transpose_item(A.in[28] + (size_t)l * D * FF, D, FF, FF, (bf16*)(F.ws + WS_WU) + (size_t)l * FF * D, scr, r, F.lane); continue; } r -= I_U;
        p0_transpose_item(A.in[29] + (size_t)l * FF * D, FF, D, D, (bf16*)(F.ws + WS_WD) + (size_t)l * D * FF, scr, r, F.lane);
    }
    if (blockIdx.x == 0 && F.wave == 0) {
        for (int l = 0; l < NL; ++l) {
            const int i = F.lane & 31; const bool on = F.lane < 32;
            const float s1 = wave_sum(on ? A.in[5][l * 32 + i] * A.in[6][l * 32 + i] : 0.f);
            const float s2 = wave_sum(on ? A.in[7][l * 32 + i] * A.in[8][l * 32 + i] : 0.f);
            const float gq = wave_max(fabsf(A.in[3][l * 32 + i])), gk = wave_max(fabsf(A.in[4][l * 32 + i]));
            const float lam_init = 0.8f - 0.6f * expf(-0.3f * (float)l);
            if (F.lane == 0) { F.LC[l * 16 + 0] = expf(s1) - expf(s2) + lam_init; F.LC[l * 16 + 1] = lam_init; F.LC[l * 16 + 2] = LOG2E * 5.656854249f * gq * gk; }
        }
    }
    if (blockIdx.x == 0 && F.wave >= 1 && F.wave <= 4) {
        const int c = (F.wave - 1) * 64 + F.lane;
        float z[NL], mx = -1e30f, sum = 0.f;
        for (int l = 0; l < NL; ++l) { z[l] = A.in[13][l * 256 + c]; mx = fmaxf(mx, z[l]); }
        for (int l = 0; l < NL; ++l) { z[l] = expf(z[l] - mx); sum += z[l]; }
        float cum = 0.f;
        for (int l = 0; l < NL; ++l) { if (l > 0) cum += z[l] / sum; F.LB[l * 256 + c] = cum; }
    }
}
__device__ __forceinline__ void norm_phase(Frame& F, const float* src, const float* gain, bf16* dst) {
    const int gw = F.vcu * NWAVES + F.wave, NGW = F.G * NWAVES;
    f32x4 gv[4];
#pragma unroll
    for (int j = 0; j < 4; ++j) gv[j] = ((const f32x4*)gain)[F.lane + 64 * j];
    for (int m = gw; m < M; m += NGW) {
        const GAS f32x4* xr = (const GAS f32x4*)(src + (size_t)m * D) + F.lane;
        f32x4 v[4]; float s = 0.f;
#pragma unroll
        for (int j = 0; j < 4; ++j) { v[j] = xr[64 * j]; s += (v[j].x * v[j].x + v[j].y * v[j].y) + (v[j].z * v[j].z + v[j].w * v[j].w); }
        const float rs = rsqrtf(wave_sum(s) * (1.f / D) + 1e-6f);
        GAS unsigned long long* o8 = (GAS unsigned long long*)(dst + (size_t)m * D) + F.lane;
#pragma unroll
        for (int j = 0; j < 4; ++j) { const f32x4 y = v[j] * rs * gv[j]; o8[64 * j] = (unsigned long long)pk2(y.x, y.y) | ((unsigned long long)pk2(y.z, y.w) << 32); }
    }
}
__device__ __forceinline__ void prep_attn(Frame& F, const Args& A, int l) {
    const int gw = F.vcu * NWAVES + F.wave, NGW = F.G * NWAVES;
    float g8[8];
    { const float* gsrc = (F.lane < 32 ? A.in[3] : A.in[4]) + l * 32 + (F.lane & 3) * 8; const float sc = F.lane < 32 ? 0.17677669529663687f * LOG2E : 1.f;
#pragma unroll
      for (int i = 0; i < 8; ++i) g8[i] = gsrc[i] * sc; }
    for (int m = gw; m < M; m += NGW) {
        GAS v4u* p = (GAS v4u*)(F.PR + (size_t)m * PINP + SA0) + F.lane;
        const v4u raw = *p; float v[8];
#pragma unroll
        for (int i = 0; i < 4; ++i) { v[2 * i] = __builtin_bit_cast(float, raw[i] << 16); v[2 * i + 1] = __builtin_bit_cast(float, raw[i] & 0xffff0000u); }
        float s = 0.f;
#pragma unroll
        for (int i = 0; i < 8; ++i) s += v[i] * v[i];
        s += __shfl_xor(s, 1); s += __shfl_xor(s, 2);
        const float rs = rsqrtf(s * (1.f / 32.f) + 1e-6f);
        v4u o;
#pragma unroll
        for (int i = 0; i < 4; ++i) o[i] = pk2(v[2 * i] * rs * g8[2 * i], v[2 * i + 1] * rs * g8[2 * i + 1]);
        *p = o;
    }
}
__device__ __forceinline__ void prep_scalars(Frame& F, const Args& A, int l, int half) {
    LAS float* lr = (LAS float*)(F.lds + RING_OFF);
    LAS float* gdl = (LAS float*)(F.lds + RING_OFF + 8192);
    float* RWS = (float*)(F.ws + WS_SC + SC_RWS); float* HS = (float*)(F.ws + WS_SC + SC_HS); float* GS = (float*)(F.ws + WS_SC + SC_GS);
    const int tid = F.tid, c = tid & 255, th = tid >> 8, h = c >> 6, lane = F.lane;
    const float* mu = A.in[15] + l * 896;
    const float mu_r = mu[c], mu_k = mu[256 + c], w0c = A.in[16][l * 256 + c], a0c = A.in[18][l * 256 + c], kkc = A.in[21][l * 256 + c], kac = A.in[22][l * 256 + c], rkc = A.in[23][l * 256 + c];
    const float lbc = F.LB[l * 256 + c];
    float wup[32], aup[32];
#pragma unroll
    for (int j = 0; j < 32; ++j) { wup[j] = A.in[17][(l * 32 + j) * 256 + c]; aup[j] = A.in[19][(l * 32 + j) * 256 + c]; }
    const int c2 = tid & 127, tq = tid >> 7, h2 = c2 >> 5;
    const float gb = A.in[11][l * 128 + c2];
    float gup[16];
#pragma unroll
    for (int j = 0; j < 16; ++j) gup[j] = A.in[10][(l * 16 + j) * 128 + c2];
    for (int u = F.vcu; u < (M / 2) / 32; u += F.G) {
        const int m0 = half * (M / 2) + u * 32, b = m0 / SEQ, t0 = m0 % SEQ, bl = b - 4 * half;
#pragma unroll
        for (int e = 0; e < 4; ++e) { const int idx = tid * 4 + e, i = idx >> 6, j = idx & 63; const size_t m = (size_t)m0 + i;
            const float raw = bf2f(F.PR[m * PINP + SD0 + 768 + j]); const float prev = (t0 + i > 0) ? bf2f(F.PR[(m - 1) * PINP + SD0 + 768 + j]) : 0.f;
            float val = raw + mu[768 + j] * (prev - raw); if (j < 32) val = tanhf(val); lr[i * 64 + j] = val; }
        { const int i = tid >> 4, j = tid & 15; gdl[i * 16 + j] = bf2f(F.PR[((size_t)m0 + i) * PINP + SB0 + 512 + j]); }
        __syncthreads();
        for (int i = 0; i < 16; ++i) {
            const int tok = th * 16 + i, t = t0 + tok; const size_t m = (size_t)m0 + tok;
            const bf16* row = F.PR + m * PINP;
            const float r_raw = bf2f(row[SD0 + c]), k_raw = bf2f(row[SD0 + 256 + c]);
            float r_prev = 0.f, k_prev = 0.f;
            if (t > 0) { r_prev = bf2f(row[SD0 + c - PINP]); k_prev = bf2f(row[SD0 + 256 + c - PINP]); }
            const float r = r_raw + mu_r * (r_prev - r_raw), k = k_raw + mu_k * (k_prev - k_raw);
            float xw = w0c, xa = a0c;
#pragma unroll
            for (int j = 0; j < 32; ++j) { xw += lr[tok * 64 + j] * wup[j]; xa += lr[tok * 64 + 32 + j] * aup[j]; }
            const float w = __expf(-0.606531f * sigmoidf_(xw)), a = sigmoidf_(xa);
            const float kk = k * kkc; const float ss = wave_sum(kk * kk); const float kkn = kk * rsqrtf(fmaxf(ss, 1e-24f));
            const float k2 = k * (1.f + (a - 1.f) * kac);
            const float bs = wave_sum(r * k2 * rkc);
            if (lane == 0) F.BS[m * 4 + h] = bs;
            float* dst = RWS + (size_t)((bl * 4 + h) * SEQ + t) * 320;
            dst[lane] = -kkn; { float* d2 = dst + 64 + (lane >> 3) * 32 + (lane & 7); d2[0] = w; d2[8] = kkn * a; d2[16] = k2; d2[24] = r; }
            const float hq = bf2f(row[SC0 + c]), hz = bf2f(row[SC0 + 256 + c]);
            float* hd = HS + (size_t)((bl * 4 + h) * SEQ + t) * 128 + (lane >> 4) * 32 + (lane & 15);
            hd[0] = hq * sigmoidf_(hq); hd[16] = (1.f - lbc) * sigmoidf_(-hz);
        }
        for (int i = 0; i < 8; ++i) {
            const int tok = tq * 8 + i, t = t0 + tok; const size_t m = (size_t)m0 + tok;
            const bf16* row = F.PR + m * PINP;
            float x = gb;
#pragma unroll
            for (int j = 0; j < 16; ++j) x += gdl[tok * 16 + j] * gup[j];
            const float ls = (x < 0.f ? x : 0.f) - log1pf(__expf(-fabsf(x)));
            const float dd = -expm1f(ls * (1.f / 16.f));
            float* gd = GS + (size_t)((bl * 4 + h2) * SEQ + t) * 128 + ((c2 & 31) >> 3) * 32 + (c2 & 7);
            gd[0] = bf2f(row[SB0 + c2]) * 0.17677669529663687f; gd[8] = bf2f(row[SB0 + 128 + c2]); gd[16] = dd;
        }
        __syncthreads();
    }
}
namespace att {
typedef __attribute__((address_space(3))) const char* lds_cptr;
typedef short v4i16_t __attribute__((ext_vector_type(4)));
typedef float f32x2_t __attribute__((ext_vector_type(2))); typedef __bf16 bf16x2_t __attribute__((ext_vector_type(2)));
constexpr int SLOTB = 8192, LDS_K = 0, LDS_V = 2 * SLOTB, LDS_WS = 4 * SLOTB, LDS_STG = LDS_WS + 2048, LDS_TOTAL = LDS_STG + NWAVES * 8192;
__device__ __forceinline__ int crow(int r, int hi) { return (r & 3) + 8 * (r >> 2) + 4 * hi; }
__device__ __forceinline__ void glds16(const void* gsrc, unsigned lds_dst) { unsigned keep;
    asm volatile("s_mov_b32 %0, m0\n\ts_mov_b32 m0, %2\n\ts_nop 0\n\tglobal_load_lds_dwordx4 %1, off\n\ts_mov_b32 m0, %0" : "=&s"(keep) : "v"(gsrc), "s"(lds_dst) : "memory"); }
__device__ __forceinline__ unsigned cvtpk_s(float lo, float hi) { f32x2_t v = {lo, hi}; bf16x2_t b = __builtin_convertvector(v, bf16x2_t); return __builtin_bit_cast(unsigned, b); }
__device__ __forceinline__ s16x4 vtr(lds_cptr p) { return __builtin_bit_cast(s16x4, __builtin_amdgcn_ds_read_tr16_b64_v4i16((__attribute__((address_space(3))) v4i16_t*)p)); }
#define ATT_WAIT_BAR() asm volatile("s_waitcnt vmcnt(0) lgkmcnt(0)\n\ts_barrier" ::: "memory")
__device__ __forceinline__ void attn_unit(int b, int h, int qb, bf16* PR, float lam, float ref2, float onemli, const float* gout, char* shm) {
    int tid_ = threadIdx.x; asm volatile("" : "+v"(tid_));
    const int tid = tid_, lane = tid & 63, r32 = lane & 31, hi = lane >> 5; const int wid = __builtin_amdgcn_readfirstlane(tid >> 6);
    const long rowbase = (long)b * SEQ; const int q0 = qb * 256;
    const bf16* Qw = PR + (rowbase + q0 + wid * 32) * PINP + SA0 + h * 64;
    const bf16* Kh = PR + rowbase * PINP + SA0 + 256 + h * 64; const bf16* Vh = PR + rowbase * PINP + SA0 + 512 + h * 64;
    const unsigned lds0 = (unsigned)(uintptr_t)shm;
    float* wsf = (float*)(shm + LDS_WS) + wid * 64;
    float* stg = (float*)(shm + LDS_STG) + wid * 2048;
    const bf16* ksrc = Kh + (long)lane * PINP + wid * 8;
    const bf16* vsrc = Vh + (long)(16 * (wid & 3) + (lane >> 2)) * PINP + (wid >> 2) * 32 + (lane & 3) * 8;
    const unsigned kdst = lds0 + LDS_K + wid * 1024, vdst = lds0 + LDS_V + wid * 1024;
#define DMA_K(t, slot) glds16(ksrc + (long)(t) * 64 * PINP, (unsigned)__builtin_amdgcn_readfirstlane(kdst + (slot)))
#define DMA_V(t, slot) glds16(vsrc + (long)(t) * 64 * PINP, (unsigned)__builtin_amdgcn_readfirstlane(vdst + (slot)))
    const lds_cptr shm3 = (lds_cptr)shm;
    const int NT = (q0 + 256) / 64;
    DMA_K(0, 0); DMA_V(0, 0);
    bf16x8 qr[4];
#pragma unroll
    for (int j = 0; j < 4; ++j) qr[j] = *reinterpret_cast<const bf16x8*>(&Qw[(long)r32 * PINP + j * 16 + hi * 8]);
    const float slope2 = LOG2E * exp2f(-2.f * (float)(h + 1));
    const int qpos = q0 + wid * 32 + r32;
    float cb[16];
#pragma unroll
    for (int r = 0; r < 16; ++r) cb[r] = slope2 * (float)crow(r, hi);
    float l1 = 0.f, l2 = 0.f; f32x16 o1[2], o2[2];
    o1[0] = f32x16{}; o1[1] = f32x16{}; o2[0] = f32x16{}; o2[1] = f32x16{};
    for (int t = 0; t < NT; ++t) {
        ATT_WAIT_BAR();
        if (t + 1 < NT) { DMA_K(t + 1, ((t + 1) & 1) * SLOTB); DMA_V(t + 1, ((t + 1) & 1) * SLOTB); }
        const int slot = (t & 1) * SLOTB;
        if (64 * t <= q0 + wid * 32 + 31) {
            const lds_cptr kp = shm3 + LDS_K + slot + hi * 1024 + r32 * 16;
            bf16x8 kf[8];
#pragma unroll
            for (int j = 0; j < 4; ++j) { kf[2 * j] = *(const __attribute__((address_space(3))) bf16x8*)(kp + j * 2048); kf[2 * j + 1] = *(const __attribute__((address_space(3))) bf16x8*)(kp + j * 2048 + 512); }
            const float tc = slope2 * (float)(64 * t - qpos) - ref2;
            f32x16 c0, c1;
#pragma unroll
            for (int r = 0; r < 16; ++r) { c0[r] = cb[r] + tc; c1[r] = c0[r] + 32.f * slope2; }
            f32x16 pa0 = __builtin_amdgcn_mfma_f32_32x32x16_bf16(kf[0], qr[0], c0, 0, 0, 0); pa0 = __builtin_amdgcn_mfma_f32_32x32x16_bf16(kf[2], qr[1], pa0, 0, 0, 0);
            f32x16 pa1 = __builtin_amdgcn_mfma_f32_32x32x16_bf16(kf[1], qr[0], c1, 0, 0, 0); pa1 = __builtin_amdgcn_mfma_f32_32x32x16_bf16(kf[3], qr[1], pa1, 0, 0, 0);
            f32x16 pb0 = __builtin_amdgcn_mfma_f32_32x32x16_bf16(kf[4], qr[2], c0, 0, 0, 0); pb0 = __builtin_amdgcn_mfma_f32_32x32x16_bf16(kf[6], qr[3], pb0, 0, 0, 0);
            f32x16 pb1 = __builtin_amdgcn_mfma_f32_32x32x16_bf16(kf[5], qr[2], c1, 0, 0, 0); pb1 = __builtin_amdgcn_mfma_f32_32x32x16_bf16(kf[7], qr[3], pb1, 0, 0, 0);
#pragma unroll
            for (int r = 0; r < 16; ++r) { pa0[r] = __builtin_amdgcn_exp2f(pa0[r]); pa1[r] = __builtin_amdgcn_exp2f(pa1[r]); pb0[r] = __builtin_amdgcn_exp2f(pb0[r]); pb1[r] = __builtin_amdgcn_exp2f(pb1[r]); }
            if (64 * t + 63 > q0 + wid * 32) {
#pragma unroll
                for (int r = 0; r < 16; ++r) { const int kv = 64 * t + crow(r, hi);
                    if (kv > qpos) { pa0[r] = 0.f; pb0[r] = 0.f; }
                    if (kv + 32 > qpos) { pa1[r] = 0.f; pb1[r] = 0.f; } }
            }
            float sa = 0.f, sb = 0.f;
#pragma unroll
            for (int r = 0; r < 16; ++r) { sa += pa0[r] + pa1[r]; sb += pb0[r] + pb1[r]; }
            l1 += sa; l2 += sb;
            u32x4 pw[4], qw[4];
#pragma unroll
            for (int i = 0; i < 4; ++i) { pw[0][i] = cvtpk_s(pa0[2 * i], pa0[2 * i + 1]); pw[1][i] = cvtpk_s(pa0[8 + 2 * i], pa0[9 + 2 * i]); pw[2][i] = cvtpk_s(pa1[2 * i], pa1[2 * i + 1]); pw[3][i] = cvtpk_s(pa1[8 + 2 * i], pa1[9 + 2 * i]);
                qw[0][i] = cvtpk_s(pb0[2 * i], pb0[2 * i + 1]); qw[1][i] = cvtpk_s(pb0[8 + 2 * i], pb0[9 + 2 * i]); qw[2][i] = cvtpk_s(pb1[2 * i], pb1[2 * i + 1]); qw[3][i] = cvtpk_s(pb1[8 + 2 * i], pb1[9 + 2 * i]); }
            const lds_cptr vp = shm3 + LDS_V + slot + ((lane >> 4) & 1) * 32 + (lane & 3) * 8 + (4 * hi + ((lane & 15) >> 2)) * 64;
#pragma unroll
            for (int d0 = 0; d0 < 2; ++d0) {
#pragma unroll
                for (int k = 0; k < 4; ++k) {
                    const s16x4 vlo = vtr(vp + d0 * 4096 + k * 1024), vhi = vtr(vp + d0 * 4096 + k * 1024 + 512);
                    const bf16x8 vf = (bf16x8){vlo[0], vlo[1], vlo[2], vlo[3], vhi[0], vhi[1], vhi[2], vhi[3]};
                    o1[d0] = __builtin_amdgcn_mfma_f32_32x32x16_bf16(__builtin_bit_cast(bf16x8, pw[k]), vf, o1[d0], 0, 0, 0);
                    o2[d0] = __builtin_amdgcn_mfma_f32_32x32x16_bf16(__builtin_bit_cast(bf16x8, qw[k]), vf, o2[d0], 0, 0, 0);
                }
            }
        }
    }
    { auto r1 = __builtin_amdgcn_permlane32_swap(__float_as_uint(l1), __float_as_uint(l1), false, false); l1 = __uint_as_float(r1[0]) + __uint_as_float(r1[1]);
      auto r2 = __builtin_amdgcn_permlane32_swap(__float_as_uint(l2), __float_as_uint(l2), false, false); l2 = __uint_as_float(r2[0]) + __uint_as_float(r2[1]); }
    if (hi == 0) { wsf[r32] = 1.f / l1; wsf[32 + r32] = lam / l2; }
    asm volatile("s_waitcnt lgkmcnt(0)" ::: "memory");
#pragma unroll
    for (int r = 0; r < 16; ++r) { const int orow = crow(r, hi); const float a1 = wsf[orow], a2 = wsf[32 + orow];
#pragma unroll
        for (int d0 = 0; d0 < 2; ++d0) stg[orow * 64 + d0 * 32 + r32] = o1[d0][r] * a1 - o2[d0][r] * a2; }
    asm volatile("s_waitcnt lgkmcnt(0)" ::: "memory");
    bf16* Ow = PR + (rowbase + q0 + wid * 32) * PINP + SA0 + h * 64;
#pragma unroll
    for (int i = 0; i < 4; ++i) { const int row = i * 8 + (lane >> 3), ch = lane & 7;
        const f32x4 x0 = *(const f32x4*)(stg + row * 64 + ch * 8), x1 = *(const f32x4*)(stg + row * 64 + ch * 8 + 4);
        float s = (x0.x * x0.x + x0.y * x0.y) + (x0.z * x0.z + x0.w * x0.w) + (x1.x * x1.x + x1.y * x1.y) + (x1.z * x1.z + x1.w * x1.w);
        s += __shfl_xor(s, 1); s += __shfl_xor(s, 2); s += __shfl_xor(s, 4);
        const float rs = rsqrtf(s * (1.f / 64.f) + 1e-6f) * onemli;
        const f32x4 g0 = *(const f32x4*)(gout + ch * 8), g1 = *(const f32x4*)(gout + ch * 8 + 4);
        u32x4 w; w.x = pk2(x0.x * rs * g0.x, x0.y * rs * g0.y); w.y = pk2(x0.z * rs * g0.z, x0.w * rs * g0.w); w.z = pk2(x1.x * rs * g1.x, x1.y * rs * g1.y); w.w = pk2(x1.z * rs * g1.z, x1.w * rs * g1.w);
        *(u32x4*)(Ow + (long)row * PINP + ch * 8) = w; }
    asm volatile("s_waitcnt lgkmcnt(0)\n\ts_barrier" ::: "memory");
#undef DMA_K
#undef DMA_V
}
}
__device__ __forceinline__ void attn_phase(Frame& F, const Args& A, int l, char* lds) {
    const float lam = F.LC[l * 16 + 0], lam_init = F.LC[l * 16 + 1], ref2 = F.LC[l * 16 + 2];
    for (int v = F.vcu; v < 256; v += F.G) {
        const int s = v & 7, bh = v >> 3;
        for (int i = 0; i < 4; ++i) {
            const int qb = (i == 0) ? s : (i == 1) ? 15 - s : (i == 2) ? 16 + s : 31 - s;
            att::attn_unit(bh >> 2, bh & 3, qb, F.PR, lam, ref2, 1.f - lam_init, A.in[9] + l * 64, lds);
        }
    }
}
typedef float sf16 __attribute__((ext_vector_type(16)));
#define PKT_LOAD(X, Y, ptr) asm volatile("s_load_dwordx16 %0, %2, 0x0 glc\n\ts_load_dwordx16 %1, %2, 0x40 glc" : "=&s"(X), "=&s"(Y) : "s"(ptr) : "memory")
#define PKT_WAIT(X, Y) asm volatile("s_waitcnt lgkmcnt(0)" : "+s"(X), "+s"(Y))
__device__ __forceinline__ void scan_rwkv(Frame& F, const Args& A, int l, int half, int bl, int h) {
    const int lane = F.lane, b = 4 * half + bl;
    const float* sc = (const float*)(F.ws + WS_SC + SC_RWS) + (size_t)((bl * 4 + h) * SEQ) * 320;
    const bf16* vcol = F.PR + (size_t)b * SEQ * PINP + SD0 + 512 + h * 64 + lane;
    bf16* ycol = F.PR + (size_t)b * SEQ * PINP + SD0 + h * 64 + lane;
    const float mu_v = A.in[15][l * 896 + 512 + h * 64 + lane];
    float S[64];
#pragma unroll
    for (int k = 0; k < 64; ++k) S[k] = 0.f;
    float vprev = 0.f;
    float vn[4];
#pragma unroll
    for (int j = 0; j < 4; ++j) vn[j] = bf2f(vcol[(size_t)j * PINP]);
    sf16 Xa, Ya, Xb, Yb;
    PKT_LOAD(Xa, Ya, sc);
    for (int t0 = 0; t0 < SEQ; t0 += 4) {
        float vc[4];
#pragma unroll
        for (int j = 0; j < 4; ++j) vc[j] = vn[j];
        if (t0 + 4 < SEQ) {
#pragma unroll
            for (int j = 0; j < 4; ++j) vn[j] = bf2f(vcol[(size_t)(t0 + 4 + j) * PINP]);
        }
#pragma unroll 1
        for (int j = 0; j < 4; ++j) {
            const float vr = vc[j]; const float v = vr + mu_v * (vprev - vr); vprev = vr;
            const float* p = sc + (size_t)(t0 + j) * 320;
            float sa = 0.f, y = 0.f;
            PKT_WAIT(Xa, Ya); PKT_LOAD(Xb, Yb, p + 32);
#pragma unroll
            for (int k = 0; k < 16; ++k) { sa += S[k] * Xa[k]; sa += S[16 + k] * Ya[k]; }
            PKT_WAIT(Xb, Yb); PKT_LOAD(Xa, Ya, p + 64);
#pragma unroll
            for (int k = 0; k < 16; ++k) { sa += S[32 + k] * Xb[k]; sa += S[48 + k] * Yb[k]; }
#define RW_CHUNK(c, X, Y, XN, YN) do { PKT_WAIT(X, Y); PKT_LOAD(XN, YN, p + 96 + 32 * (c)); \
            _Pragma("unroll") for (int k = 0; k < 8; ++k) { float s = S[8 * (c) + k]; s = s * X[k] + sa * X[8 + k] + v * Y[k]; y += s * Y[8 + k]; S[8 * (c) + k] = s; } } while (0)
            RW_CHUNK(0, Xa, Ya, Xb, Yb); RW_CHUNK(1, Xb, Yb, Xa, Ya); RW_CHUNK(2, Xa, Ya, Xb, Yb); RW_CHUNK(3, Xb, Yb, Xa, Ya);
            RW_CHUNK(4, Xa, Ya, Xb, Yb); RW_CHUNK(5, Xb, Yb, Xa, Ya); RW_CHUNK(6, Xa, Ya, Xb, Yb); RW_CHUNK(7, Xb, Yb, Xa, Ya);
#undef RW_CHUNK
            ycol[(size_t)(t0 + j) * PINP] = (bf16)f2bf(y);
        }
    }
    PKT_WAIT(Xa, Ya);
}
__device__ __forceinline__ void scan_hgrn(Frame& F, int half, int bl, int h) {
    const int lane = F.lane, b = 4 * half + bl;
    const float* sc = (const float*)(F.ws + WS_SC + SC_HS) + (size_t)((bl * 4 + h) * SEQ) * 128;
    const bf16* vcol = F.PR + (size_t)b * SEQ * PINP + SC0 + 512 + h * 64 + lane;
    bf16* ycol = F.PR + (size_t)b * SEQ * PINP + SC0 + h * 64 + lane;
    float S[64];
#pragma unroll
    for (int k = 0; k < 64; ++k) S[k] = 0.f;
    float vn[4];
#pragma unroll
    for (int j = 0; j < 4; ++j) vn[j] = bf2f(vcol[(size_t)j * PINP]);
    sf16 Xa, Ya, Xb, Yb;
    PKT_LOAD(Xa, Ya, sc);
    for (int t0 = 0; t0 < SEQ; t0 += 4) {
        float vc[4];
#pragma unroll
        for (int j = 0; j < 4; ++j) vc[j] = vn[j];
        if (t0 + 4 < SEQ) {
#pragma unroll
            for (int j = 0; j < 4; ++j) vn[j] = bf2f(vcol[(size_t)(t0 + 4 + j) * PINP]);
        }
#pragma unroll 1
        for (int j = 0; j < 4; ++j) {
            const float v = vc[j];
            const float* p = sc + (size_t)(t0 + j) * 128;
            float y = 0.f;
#define HG_CHUNK(c, X, Y, XN, YN) do { PKT_WAIT(X, Y); PKT_LOAD(XN, YN, p + 32 + 32 * (c)); \
            _Pragma("unroll") for (int k = 0; k < 16; ++k) { float s = S[16 * (c) + k]; s += Y[k] * (v - s); y += X[k] * s; S[16 * (c) + k] = s; } } while (0)
            HG_CHUNK(0, Xa, Ya, Xb, Yb); HG_CHUNK(1, Xb, Yb, Xa, Ya); HG_CHUNK(2, Xa, Ya, Xb, Yb); HG_CHUNK(3, Xb, Yb, Xa, Ya);
#undef HG_CHUNK
            ycol[(size_t)(t0 + j) * PINP] = (bf16)f2bf(y);
        }
    }
    PKT_WAIT(Xa, Ya);
}
__device__ __forceinline__ void scan_gla(Frame& F, int half, int bl, int h) {
    const int lane = F.lane, b = 4 * half + bl;
    const float* sc = (const float*)(F.ws + WS_SC + SC_GS) + (size_t)((bl * 4 + h) * SEQ) * 128;
    const bf16* vcol = F.PR + (size_t)b * SEQ * PINP + SB0 + 256 + h * 64 + lane;
    bf16* ycol = F.PR + (size_t)b * SEQ * PINP + SB0 + h * 64 + lane;
    float S[32];
#pragma unroll
    for (int k = 0; k < 32; ++k) S[k] = 0.f;
    float vn[4];
#pragma unroll
    for (int j = 0; j < 4; ++j) vn[j] = bf2f(vcol[(size_t)j * PINP]);
    sf16 Xa, Ya, Xb, Yb;
    PKT_LOAD(Xa, Ya, sc);
    for (int t0 = 0; t0 < SEQ; t0 += 4) {
        float vc[4];
#pragma unroll
        for (int j = 0; j < 4; ++j) vc[j] = vn[j];
        if (t0 + 4 < SEQ) {
#pragma unroll
            for (int j = 0; j < 4; ++j) vn[j] = bf2f(vcol[(size_t)(t0 + 4 + j) * PINP]);
        }
#pragma unroll 1
        for (int j = 0; j < 4; ++j) {
            const float v = vc[j];
            const float* p = sc + (size_t)(t0 + j) * 128;
            float y = 0.f;
#define GL_CHUNK(c, X, Y, XN, YN) do { PKT_WAIT(X, Y); PKT_LOAD(XN, YN, p + 32 + 32 * (c)); \
            _Pragma("unroll") for (int k = 0; k < 8; ++k) { float s = S[8 * (c) + k]; s = s - Y[k] * s + X[8 + k] * v; y += X[k] * s; S[8 * (c) + k] = s; } } while (0)
            GL_CHUNK(0, Xa, Ya, Xb, Yb); GL_CHUNK(1, Xb, Yb, Xa, Ya); GL_CHUNK(2, Xa, Ya, Xb, Yb); GL_CHUNK(3, Xb, Yb, Xa, Ya);
#undef GL_CHUNK
            ycol[(size_t)(t0 + j) * PINP] = (bf16)f2bf(y);
        }
    }
    PKT_WAIT(Xa, Ya);
}
__device__ __forceinline__ void scan_phase(Frame& F, const Args& A, int l, int half) {
    const int gw = F.wave * F.G + (int)blockIdx.x;
    if (gw < 16) scan_rwkv(F, A, l, half, gw >> 2, gw & 3);
    else if (gw < 32) scan_hgrn(F, half, (gw - 16) >> 2, gw & 3);
    else if (gw < 48) scan_gla(F, half, (gw - 32) >> 2, gw & 3);
}
__device__ __forceinline__ void finalize_phase(Frame& F, const Args& A, int l) {
    LAS float* sg = (LAS float*)(F.lds + RING_OFF);
    const int tid = F.tid, c = tid & 255, th = tid >> 8, h = c >> 6;
    const float* mu = A.in[15] + l * 896;
    const float gla_g = A.in[12][l * 64 + (c & 63)], hg_g = A.in[14][l * 64 + (c & 63)], lng = A.in[24][l * 256 + c], lnb = A.in[25][l * 256 + c], mu_v = mu[512 + c];
    float gup[64];
#pragma unroll
    for (int j = 0; j < 64; ++j) gup[j] = A.in[20][(l * 64 + j) * 256 + c];
    for (int u = F.vcu; u < M / 32; u += F.G) {
        const int m0 = u * 32, t0 = m0 % SEQ;
#pragma unroll
        for (int e = 0; e < 4; ++e) { const int idx = tid * 4 + e, i = idx >> 6, j = idx & 63; const size_t m = (size_t)m0 + i;
            const float raw = bf2f(F.PR[m * PINP + SD0 + 832 + j]); const float prev = (t0 + i > 0) ? bf2f(F.PR[(m - 1) * PINP + SD0 + 832 + j]) : 0.f;
            sg[i * 64 + j] = sigmoidf_(raw + mu[832 + j] * (prev - raw)); }
        __syncthreads();
        for (int i = 0; i < 16; ++i) {
            const int tok = th * 16 + i, t = t0 + tok; const size_t m = (size_t)m0 + tok;
            bf16* row = F.PR + m * PINP;
            const bf16 oa = row[SA0 + c];
            float y = bf2f(row[SB0 + c]); float ms = wave_sum(y * y) * (1.f / 64.f);
            float og = bf2f(row[SB0 + 528 + c]);
            const float ob = y * rsqrtf(ms + 1e-6f) * gla_g * og * sigmoidf_(og);
            y = bf2f(row[SC0 + c]); ms = wave_sum(y * y) * (1.f / 64.f);
            og = bf2f(row[SC0 + 768 + c]);
            const float oc = y * rsqrtf(ms + 1e-6f) * hg_g * og * sigmoidf_(og);
            y = bf2f(row[SD0 + c]); const float mean = wave_sum(y) * (1.f / 64.f); const float dy = y - mean; const float var = wave_sum(dy * dy) * (1.f / 64.f);
            const float yn = dy * rsqrtf(var + 64e-5f) * lng + lnb;
            const float vr = bf2f(row[SD0 + 512 + c]); const float vp = (t > 0) ? bf2f(row[SD0 + 512 + c - PINP]) : 0.f;
            const float v = vr + mu_v * (vp - vr);
            float g = 0.f;
#pragma unroll
            for (int j = 0; j < 64; ++j) g += sg[tok * 64 + j] * gup[j];
            const float od = (yn + F.BS[m * 4 + h] * v) * g;
            row[SC0 + c] = oa; row[SC0 + 256 + c] = (bf16)f2bf(ob); row[SC0 + 512 + c] = (bf16)f2bf(oc); row[SC0 + 768 + c] = (bf16)f2bf(od);
        }
        __syncthreads();
    }
}
__global__ void __launch_bounds__(NWAVES * 64, 2) fwd_kernel(Args args) {
    extern __shared__ __attribute__((aligned(16))) unsigned char lds[];
    Frame F;
    F.lds = (LAS unsigned char*)lds;
    F.MISC = (volatile LAS unsigned*)(F.lds + MISC_OFF);
    F.tid = threadIdx.x; F.lane = F.tid & 63; F.wave = __builtin_amdgcn_readfirstlane(F.tid >> 6);
    F.G = gridDim.x; { const int bx = blockIdx.x; F.vcu = (F.G % 8 == 0) ? (bx % 8) * (F.G / 8) + bx / 8 : bx; }
    unsigned char* ws = args.ws; F.ws = ws; F.out = args.out;
    F.ctl = (gu32*)(ws + WS_CTL);
    F.PR = (bf16*)(ws + WS_PR); F.X2 = (bf16*)(ws + WS_X2); F.HB = (bf16*)(ws + WS_H); F.ZG = (bf16*)(ws + WS_ZG);
    F.LC = (float*)(ws + WS_LC); F.LB = (float*)(ws + WS_LB); F.BS = (float*)(ws + WS_BS);
    for (int u = F.tid; u < (LDS_BYTES - LDSCTL_OFF) / 4; u += NWAVES * 64) ((LAS unsigned*)(F.lds + LDSCTL_OFF))[u] = 0u;
    __syncthreads();
    XcdBarrier bar = xcd_barrier_post((unsigned*)(F.ctl + CW_BAR), F.MISC + 8);
    int bid = (int)blockIdx.x;
#define RELAUNDER() do { int t_ = threadIdx.x; asm volatile("" : "+v"(t_)); F.tid = t_; F.lane = t_ & 63; F.wave = __builtin_amdgcn_readfirstlane(t_ >> 6); \
    int b_ = blockIdx.x; asm volatile("" : "+s"(b_)); bid = b_; F.vcu = (F.G % 8 == 0) ? (b_ % 8) * (F.G / 8) + b_ / 8 : b_; } while (0)
#define GRID_BAR() do { xcd_barrier(bar); RELAUNDER(); } while (0)

#ifndef NO_P0
    p0_prologue(F, args);
#endif
    GRID_BAR();
    for (int l = 0; l < NL; ++l) {
        const float* xsrc = (l == 0) ? args.in[0] : F.out;
        norm_phase(F, xsrc, args.in[1] + l * D, F.X2);
        GRID_BAR();
        { pg8::Gemm g{F.X2, (const bf16*)(ws + WS_WI) + (size_t)l * PINP * D, M, PINP, D, D}; pg8::StaticOrder S; S.init(M, PINP, F.G, bid);
          pg8::EpiStoreBf16<0> E{F.PR, PINP};
          pg8::gemm_phase<pg8::EpiStoreBf16<0>, pg8::StaticOrder, true, true>(F.lds + RING_OFF, g, S, E); }
        GRID_BAR();
#ifndef NO_PA
        prep_attn(F, args, l);
#endif
#ifndef NO_PS
        prep_scalars(F, args, l, 0);
#endif
        GRID_BAR();
#ifndef NO_AT
        attn_phase(F, args, l, (char*)lds + RING_OFF);
#endif
#ifndef NO_SC
        scan_phase(F, args, l, 0);
#endif
        GRID_BAR();
#ifndef NO_PS
        prep_scalars(F, args, l, 1);
#endif
        GRID_BAR();
#ifndef NO_SC
        scan_phase(F, args, l, 1);
#endif
        GRID_BAR();
#ifndef NO_FI
        finalize_phase(F, args, l);
#endif
        GRID_BAR();
        { pg8::Gemm g{F.PR + SC0, (const bf16*)(ws + WS_WO) + (size_t)l * D * D, M, D, D, PINP}; pg8::StaticOrder S; S.init(M, D, F.G, bid);
          pg8::EpiResid E{xsrc, F.out, D};
          pg8::gemm_phase<pg8::EpiResid, pg8::StaticOrder, true, true>(F.lds + RING_OFF, g, S, E); }
        GRID_BAR();
        norm_phase(F, F.out, args.in[27] + l * D, F.X2);
        GRID_BAR();
        { pg8::Gemm g{F.X2, (const bf16*)(ws + WS_WU) + (size_t)l * FF * D, M, FF, D, D}; pg8::StaticOrder S; S.init(M, FF, F.G, bid);
          pg8::EpiStoreBf16<1> E{F.HB, FF};
          pg8::gemm_phase<pg8::EpiStoreBf16<1>, pg8::StaticOrder, true, true>(F.lds + RING_OFF, g, S, E); }
        GRID_BAR();
        { pg8::Gemm g{F.HB, (const bf16*)(ws + WS_WD) + (size_t)l * D * FF, M, D, FF, FF}; pg8::StaticOrder S; S.init(M, D, F.G, bid);
          pg8::EpiResid E{F.out, F.out, D};
          pg8::gemm_phase<pg8::EpiResid, pg8::StaticOrder, true, true>(F.lds + RING_OFF, g, S, E); }
        GRID_BAR();
    }
}

extern "C" void kernel_launch(void* const* d_in, const int* in_sizes, int n_in, void* d_out, int out_size, void* d_ws, size_t ws_size, hipStream_t stream) {
    static int grid = 0;
    if (grid == 0) {
        if (n_in != 30 || out_size != M * D || ws_size < WS_END) { fprintf(stderr, "kernel_launch: unexpected shapes (n_in %d, out %d, ws %zu < %zu)\n", n_in, out_size, ws_size, (size_t)WS_END); grid = -1; return; }
        int dev = 0, cus = 0, per_cu = 0;
        if (hipGetDevice(&dev) != hipSuccess || hipDeviceGetAttribute(&cus, hipDeviceAttributeMultiprocessorCount, dev) != hipSuccess) { grid = -1; return; }
        if (hipFuncSetAttribute((const void*)fwd_kernel, hipFuncAttributeMaxDynamicSharedMemorySize, LDS_BYTES) != hipSuccess) { fprintf(stderr, "kernel_launch: hipFuncSetAttribute failed\n"); grid = -1; return; }
        if (hipOccupancyMaxActiveBlocksPerMultiprocessor(&per_cu, (const void*)fwd_kernel, NWAVES * 64, LDS_BYTES) != hipSuccess || per_cu < 1)
            fprintf(stderr, "kernel_launch: occupancy query reports %d blocks per CU\n", per_cu);
        (void)hipGetLastError();
        grid = cus;
    }
    if (grid < 0) return;
    if (hipMemsetAsync((char*)d_ws + WS_CTL, 0, CTL_ZERO_BYTES, stream) != hipSuccess) return;
    Args a{};
    for (int i = 0; i < 30; ++i) a.in[i] = (const float*)d_in[i];
    a.out = (float*)d_out; a.ws = (unsigned char*)d_ws;
    hipLaunchKernelGGL(fwd_kernel, dim3(grid), dim3(NWAVES * 64), LDS_BYTES, stream, a);
}
```

```cpp
#define RWC_STAGE 4
#include <hip/hip_runtime.h>
#include <cstdio>
#include <cstdint>
#include <cmath>
#define LANE_ID() ({ unsigned m_ = ~0u; asm volatile("" : "+s"(m_)); (int)__builtin_amdgcn_mbcnt_hi(m_, __builtin_amdgcn_mbcnt_lo(m_, 0u)); })
#define RS_EPS(sum, inv_n, eps_n) ({ float t_ = (sum) + (eps_n); asm volatile("" : "+v"(t_)); __builtin_amdgcn_rsqf(t_ * (inv_n)); })
namespace pg8 {
#define PG8_LAS __attribute__((address_space(3)))
typedef unsigned short bf16_t;
typedef short bf16x8 __attribute__((ext_vector_type(8)));
typedef float f32x4 __attribute__((ext_vector_type(4)));
typedef unsigned u32x4 __attribute__((ext_vector_type(4)));
constexpr int BM = 256, BK = 64, HALF = 128, HTB = HALF * BK * 2  , STAGE_BYTES = 8 * HTB, NXCD = 8, WGM = 8;

__host__ __device__ __forceinline__ int lds_byte(int r, int c) { const int st = (r >> 4) * 2 + (c >> 5), rr = r & 15, cc = c & 31, ob = rr * 64 + cc * 2; return st * 1024 + (ob ^ (((ob >> 9) & 1) << 5)); }
__host__ __device__ __forceinline__ void stage_rc(int b, int& R, int& C) { const int st = b / 1024, sb = b % 1024, swz = sb ^ (((sb >> 9) & 1) << 5); R = (st >> 1) * 16 + swz / 64; C = (st & 1) * 32 + (swz % 64) / 2; }
__host__ __device__ __forceinline__ int perm32(int rho) { const int n = rho >> 4, i = rho & 15; return 8 * (i >> 2) + 4 * n + (i & 3); }

struct Unit { int pm, pn; };
struct Gemm { const bf16_t* A; const bf16_t* Bt; int M, N, K, lda; };

struct StaticOrder {
    int nM, nN, nwg, G, c;
    __host__ __device__ void init(int M, int N, int G_, int c_) { nM = M / BM; nN = N / BM; nwg = nM * nN; G = G_; c = c_; }
    __host__ __device__ bool next(int i, Unit& u) const {
        const long L = (long)i * G + c; if (L >= nwg) return false;
        int wgid = (int)L; { const int q = nwg / NXCD, r = nwg % NXCD, xcd = wgid % NXCD, off = wgid / NXCD; wgid = (xcd < r ? xcd * (q + 1) : r * (q + 1) + (xcd - r) * q) + off; }
        const int nig = WGM * nN, gid = wgid / nig, fm = gid * WGM, gsz = (nM - fm) < WGM ? (nM - fm) : WGM;
        u.pm = fm + ((wgid % nig) % gsz); u.pn = (wgid % nig) / gsz; return true;
    }
    __device__ __forceinline__ void a_ready(const Unit&) const {}
    __device__ __forceinline__ void done(const Unit&) const {}
};

__device__ __forceinline__ unsigned cvt_pk_bf16(float lo, float hi) { unsigned r; asm volatile("v_cvt_pk_bf16_f32 %0, %1, %2" : "=v"(r) : "v"(lo), "v"(hi)); return r; }
typedef float f32x2 __attribute__((ext_vector_type(2)));
#define EPI_ROW_RS(rs8, SSp, row0, fq) do { f32x4 p_[8]; \
        _Pragma("unroll") for (int i_ = 0; i_ < 8; ++i_) p_[i_] = *(const f32x4*)((SSp) + (size_t)((row0) + (i_ >> 2) * HALF + (i_ & 3) * 16) * 16 + 4 * (fq)); \
        asm volatile("" : "+v"(p_[0]), "+v"(p_[1]), "+v"(p_[2]), "+v"(p_[3]), "+v"(p_[4]), "+v"(p_[5]), "+v"(p_[6]), "+v"(p_[7])); \
        _Pragma("unroll") for (int i_ = 0; i_ < 8; ++i_) { float ssr = (p_[i_][0] + p_[i_][1]) + (p_[i_][2] + p_[i_][3]);       \
            { auto r = __builtin_amdgcn_permlane16_swap(__float_as_uint(ssr), __float_as_uint(ssr), false, false); ssr = __uint_as_float(r[0]) + __uint_as_float(r[1]); } \
            { auto r = __builtin_amdgcn_permlane32_swap(__float_as_uint(ssr), __float_as_uint(ssr), false, false); ssr = __uint_as_float(r[0]) + __uint_as_float(r[1]); } \
            float rsn = ssr + 1.024e-3f; asm volatile("" : "+v"(rsn)); rs8[i_] = __builtin_amdgcn_rsqf(rsn * (1.f / 1024.f)); } } while (0)
template <int ACT  > struct EpiStoreBf16 {
    static constexpr bool PERM = true, AFTER_DRAIN = false;
    bf16_t* O; int ldc; const float* SS;
    mutable float rs8[8]; mutable int cpm = -1;
    __device__ __forceinline__ void operator()(const f32x4 (&acc)[2][2][4][2], const Unit& u, int wr, int wc, int fr, int fq) const {
        const int row0 = u.pm * BM + wr * 64 + fr, col0 = u.pn * BM + wc * 32 + 8 * fq;
        if (u.pm != cpm) { EPI_ROW_RS(rs8, SS, row0, fq); cpm = u.pm; }
#pragma unroll
        for (int ai = 0; ai < 2; ++ai)
#pragma unroll
            for (int m = 0; m < 4; ++m) { bf16_t* rowp = O + (size_t)(row0 + ai * HALF + m * 16) * ldc + col0;
                const float rsn = rs8[ai * 4 + m];
#pragma unroll
                for (int bj = 0; bj < 2; ++bj) { f32x4 v0 = acc[ai][bj][m][0] * rsn, v1 = acc[ai][bj][m][1] * rsn;
                    if (ACT == 1) { const f32x4 z = {0.f, 0.f, 0.f, 0.f}; v0 = __builtin_elementwise_max(v0, z); v1 = __builtin_elementwise_max(v1, z); v0 = v0 * v0; v1 = v1 * v1; }
                    u32x4 w; w.x = cvt_pk_bf16(v0[0], v0[1]); w.y = cvt_pk_bf16(v0[2], v0[3]); w.z = cvt_pk_bf16(v1[0], v1[1]); w.w = cvt_pk_bf16(v1[2], v1[3]);
                    *(u32x4*)(rowp + bj * HALF) = w; } }
    }
};
struct EpiInProj {
    static constexpr bool PERM = true, AFTER_DRAIN = false;
    bf16_t* O; int ldc; const float* gq; const float* gk; const float* SS;
    mutable float rs8[8]; mutable int cpm = -1;
    __device__ __forceinline__ void operator()(const f32x4 (&acc)[2][2][4][2], const Unit& u, int wr, int wc, int fr, int fq) const {
        const int row0 = u.pm * BM + wr * 64 + fr, col0 = u.pn * BM + wc * 32 + 8 * fq;
        const bool nrm = u.pn < 2;
        f32x4 g0 = {1.f, 1.f, 1.f, 1.f}, g1 = g0;
        if (nrm) { const float* gs = (u.pn == 0 ? gq : gk) + 8 * fq; const float sc = (u.pn == 0) ? 0.17677669529663687f * 1.4426950408889634f : 1.f;
            g0 = *(const f32x4*)gs * sc; g1 = *(const f32x4*)(gs + 4) * sc; }
        if (u.pm != cpm) { EPI_ROW_RS(rs8, SS, row0, fq); cpm = u.pm; }
#pragma unroll
        for (int ai = 0; ai < 2; ++ai)
#pragma unroll
            for (int m = 0; m < 4; ++m) { bf16_t* rowp = O + (size_t)(row0 + ai * HALF + m * 16) * ldc + col0;
                const float rsn = rs8[ai * 4 + m];
#pragma unroll
                for (int bj = 0; bj < 2; ++bj) { f32x4 v0 = acc[ai][bj][m][0] * rsn, v1 = acc[ai][bj][m][1] * rsn;
                    if (nrm) { float ss = (v0[0] * v0[0] + v0[1] * v0[1]) + (v0[2] * v0[2] + v0[3] * v0[3]) + (v1[0] * v1[0] + v1[1] * v1[1]) + (v1[2] * v1[2] + v1[3] * v1[3]);
                        { auto r = __builtin_amdgcn_permlane16_swap(__float_as_uint(ss), __float_as_uint(ss), false, false); ss = __uint_as_float(r[0]) + __uint_as_float(r[1]); }
                        { auto r = __builtin_amdgcn_permlane32_swap(__float_as_uint(ss), __float_as_uint(ss), false, false); ss = __uint_as_float(r[0]) + __uint_as_float(r[1]); }
                        const float rs = RS_EPS(ss, 1.f / 32.f, 32e-6f);
                        v0 = v0 * rs * g0; v1 = v1 * rs * g1; }
                    u32x4 w; w.x = cvt_pk_bf16(v0[0], v0[1]); w.y = cvt_pk_bf16(v0[2], v0[3]); w.z = cvt_pk_bf16(v1[0], v1[1]); w.w = cvt_pk_bf16(v1[2], v1[3]);
                    *(u32x4*)(rowp + bj * HALF) = w; } }
    }
};
template <bool LAST> struct EpiResidB {
    static constexpr bool PERM = true, AFTER_DRAIN = false;
    bf16_t* XB; float* O; float* SS; int ldc;
    __device__ __forceinline__ void operator()(const f32x4 (&acc)[2][2][4][2], const Unit& u, int wr, int wc, int fr, int fq) const {
        const int row0 = u.pm * BM + wr * 64 + fr, col0 = u.pn * BM + wc * 32 + 8 * fq;
        u32x4 rbv[2][4][2];
#pragma unroll
        for (int ai = 0; ai < 2; ++ai)
#pragma unroll
            for (int m = 0; m < 4; ++m)
#pragma unroll
                for (int bj = 0; bj < 2; ++bj) rbv[ai][m][bj] = *(const u32x4*)(XB + (size_t)(row0 + ai * HALF + m * 16) * ldc + col0 + bj * HALF);
        asm volatile("" : "+v"(rbv[0][0][0]), "+v"(rbv[0][0][1]), "+v"(rbv[0][1][0]), "+v"(rbv[0][1][1]), "+v"(rbv[0][2][0]), "+v"(rbv[0][2][1]), "+v"(rbv[0][3][0]), "+v"(rbv[0][3][1]),
                         "+v"(rbv[1][0][0]), "+v"(rbv[1][0][1]), "+v"(rbv[1][1][0]), "+v"(rbv[1][1][1]), "+v"(rbv[1][2][0]), "+v"(rbv[1][2][1]), "+v"(rbv[1][3][0]), "+v"(rbv[1][3][1]));
#pragma unroll
        for (int ai = 0; ai < 2; ++ai)
#pragma unroll
            for (int m = 0; m < 4; ++m) { const int row = row0 + ai * HALF + m * 16; const size_t off = (size_t)row * ldc + col0; float ss = 0.f;
#pragma unroll
                for (int bj = 0; bj < 2; ++bj) { const u32x4 rb = rbv[ai][m][bj];
                    f32x4 x0, x1;
                    x0[0] = __builtin_bit_cast(float, rb.x << 16); x0[1] = __builtin_bit_cast(float, rb.x & 0xffff0000u); x0[2] = __builtin_bit_cast(float, rb.y << 16); x0[3] = __builtin_bit_cast(float, rb.y & 0xffff0000u);
                    x1[0] = __builtin_bit_cast(float, rb.z << 16); x1[1] = __builtin_bit_cast(float, rb.z & 0xffff0000u); x1[2] = __builtin_bit_cast(float, rb.w << 16); x1[3] = __builtin_bit_cast(float, rb.w & 0xffff0000u);
                    x0 = x0 + acc[ai][bj][m][0]; x1 = x1 + acc[ai][bj][m][1];
                    if (LAST) { *(f32x4*)(O + off + bj * HALF) = x0; *(f32x4*)(O + off + bj * HALF + 4) = x1; }
                    else { u32x4 w; w.x = cvt_pk_bf16(x0[0], x0[1]); w.y = cvt_pk_bf16(x0[2], x0[3]); w.z = cvt_pk_bf16(x1[0], x1[1]); w.w = cvt_pk_bf16(x1[2], x1[3]);
                        *(u32x4*)(XB + off + bj * HALF) = w;
                        ss += (x0[0] * x0[0] + x0[1] * x0[1]) + (x0[2] * x0[2] + x0[3] * x0[3]) + (x1[0] * x1[0] + x1[1] * x1[1]) + (x1[2] * x1[2] + x1[3] * x1[3]); } }
                if (!LAST) {
                    { auto r = __builtin_amdgcn_permlane16_swap(__float_as_uint(ss), __float_as_uint(ss), false, false); ss = __uint_as_float(r[0]) + __uint_as_float(r[1]); }
                    { auto r = __builtin_amdgcn_permlane32_swap(__float_as_uint(ss), __float_as_uint(ss), false, false); ss = __uint_as_float(r[0]) + __uint_as_float(r[1]); }
                    if (fq == 0) SS[(size_t)row * 16 + u.pn * 4 + wc] = ss; } }
    }
};
template <class Epi, class Sched, bool ALIGN_EPI = false, bool SP2 = false>
__device__ __forceinline__ void gemm_phase(PG8_LAS unsigned char* lds, const Gemm g, const Sched& S, const Epi& E, int wave0) {
    int tid_ = wave0 * 64 + LANE_ID(); asm volatile("" : "+v"(tid_));
    const int tid = tid_, wid = __builtin_amdgcn_readfirstlane(tid >> 6), lane = tid & 63, wr = wid >> 2, wc = wid & 3, fr = lane & 15, fq = lane >> 4;
    const int K = g.K, nt = K / BK;
    unsigned voffA[2], voffB[2];
#pragma unroll
    for (int i = 0; i < 2; ++i) { int R, C; stage_rc(tid * 16 + i * 8192, R, C); const int Rb = Epi::PERM ? ((R & ~31) + perm32(R & 31)) : R;
        voffA[i] = (unsigned)(R * g.lda + C) * 2u; voffB[i] = (unsigned)(Rb * K + C) * 2u; }
    const size_t kstep = (size_t)(BK * 2);
    const size_t hstep = (size_t)HALF * K * 2;
    const size_t tstep = 2 * hstep; const size_t hstepA = (size_t)HALF * g.lda * 2, tstepA = 2 * hstepA;
    const unsigned ldsw = (unsigned)wid * 1024u;
    const int aoff = lds_byte(wr * 64 + fr, fq * 8), boff = lds_byte(wc * 32 + fr, fq * 8);
#define PG8_SA(b, h) (((b) * 2 + (h)) * HTB)
#define PG8_SB(b, h) ((4 + (b) * 2 + (h)) * HTB)
#define PG8_STAGE(bufoff, gbase, voff) do { _Pragma("unroll") for (int _i = 0; _i < 2; ++_i) \
        __builtin_amdgcn_global_load_lds((const unsigned*)((const char*)(gbase) + (voff)[_i]), (PG8_LAS unsigned*)(lds + (bufoff) + ldsw + _i * 8192), 16, 0, 0); } while (0)
#define PG8_LDA(dst, b, h) do { _Pragma("unroll") for (int m = 0; m < 4; ++m) _Pragma("unroll") for (int k = 0; k < 2; ++k) dst[m][k] = *(const PG8_LAS bf16x8*)(lds + PG8_SA(b, h) + aoff + m * 2048 + k * 1024); } while (0)
#define PG8_LDB(dst, b, h) do { _Pragma("unroll") for (int n = 0; n < 2; ++n) _Pragma("unroll") for (int k = 0; k < 2; ++k) dst[n][k] = *(const PG8_LAS bf16x8*)(lds + PG8_SB(b, h) + boff + n * 2048 + k * 1024); } while (0)
#define PG8_MMA(ai, bj, At, Bt) do { __builtin_amdgcn_s_setprio(1); _Pragma("unroll") for (int m = 0; m < 4; ++m) _Pragma("unroll") for (int n = 0; n < 2; ++n) _Pragma("unroll") for (int k = 0; k < 2; ++k) \
        acc[ai][bj][m][n] = __builtin_amdgcn_mfma_f32_16x16x32_bf16(Bt[n][k], At[m][k], acc[ai][bj][m][n], 0, 0, 0); __builtin_amdgcn_s_setprio(0); } while (0)
#define PG8_WAIT_V(n) asm volatile("s_waitcnt vmcnt(" #n ")" ::: "memory")
#define PG8_WAIT_L(n) asm volatile("s_waitcnt lgkmcnt(" #n ")" ::: "memory")
#define PG8_BAR __builtin_amdgcn_s_barrier()
#define PG8_SCHED __builtin_amdgcn_sched_barrier(0)
    Unit cur, nxt; int ui = 0;
    if (!S.next(0, cur)) return;
    f32x4 acc[2][2][4][2];
#pragma unroll
    for (int a = 0; a < 2; ++a)
#pragma unroll
        for (int b = 0; b < 2; ++b)
#pragma unroll
            for (int m = 0; m < 4; ++m)
#pragma unroll
                for (int n = 0; n < 2; ++n) acc[a][b][m][n] = (f32x4){0.f, 0.f, 0.f, 0.f};
    bf16x8 At[4][2], B0[2][2], B1[2][2];
    const char* cA = (const char*)g.A + (size_t)cur.pm * tstepA; const char* cB = (const char*)g.Bt + (size_t)cur.pn * tstep;
    S.a_ready(cur);
    if constexpr (SP2) {
        PG8_STAGE(PG8_SB(0, 0), cB, voffB); PG8_STAGE(PG8_SB(0, 1), cB + hstep, voffB); PG8_STAGE(PG8_SA(0, 0), cA, voffA); PG8_STAGE(PG8_SA(0, 1), cA + hstepA, voffA);
        if (wr == 1) PG8_BAR;
        PG8_WAIT_V(2); PG8_BAR;
        PG8_STAGE(PG8_SB(1, 0), cB + kstep, voffB); PG8_STAGE(PG8_SA(1, 0), cA + kstep, voffA); PG8_STAGE(PG8_SB(1, 1), cB + hstep + kstep, voffB);
        PG8_WAIT_V(6); PG8_BAR;
    } else {
        PG8_STAGE(PG8_SB(0, 0), cB, voffB); PG8_STAGE(PG8_SA(0, 0), cA, voffA); PG8_STAGE(PG8_SB(0, 1), cB + hstep, voffB); PG8_STAGE(PG8_SA(0, 1), cA + hstepA, voffA);
        if (wr == 1) PG8_BAR;
        PG8_WAIT_V(4); PG8_BAR;
        PG8_STAGE(PG8_SB(1, 0), cB + kstep, voffB); PG8_STAGE(PG8_SA(1, 0), cA + kstep, voffA); PG8_STAGE(PG8_SB(1, 1), cB + hstep + kstep, voffB);
        PG8_WAIT_V(6); PG8_BAR;
    }
    for (;;) {
        const bool has_next = S.next(ui + 1, nxt);
        const char* nA = has_next ? (const char*)g.A + (size_t)nxt.pm * tstepA : cA; const char* nB = has_next ? (const char*)g.Bt + (size_t)nxt.pn * tstep : cB;
        for (int t = 0; t < nt; t += 2) {
            const bool last = (t == nt - 2);
            const char* a1 = cA + (size_t)(t + 1) * kstep;
            const char* a2 = last ? nA : cA + (size_t)(t + 2) * kstep; const char* b2 = last ? nB : cB + (size_t)(t + 2) * kstep;
            const char* a3 = a2 + kstep; const char* b3 = b2 + kstep;
            if (last && has_next) S.a_ready(nxt);
            if constexpr (SP2) {
            PG8_LDB(B0, 0, 0); PG8_LDB(B1, 0, 1); PG8_SCHED; PG8_LDA(At, 0, 0); PG8_STAGE(PG8_SA(1, 1), a1 + hstepA, voffA);
            PG8_WAIT_V(8); PG8_WAIT_L(0); PG8_BAR; PG8_MMA(0, 0, At, B0); PG8_MMA(0, 1, At, B1); PG8_BAR; PG8_SCHED;
            PG8_LDA(At, 0, 1); PG8_STAGE(PG8_SB(0, 0), b2, voffB); PG8_STAGE(PG8_SB(0, 1), b2 + hstep, voffB); PG8_STAGE(PG8_SA(0, 0), a2, voffA);
            PG8_WAIT_V(8); PG8_WAIT_L(0); PG8_BAR; PG8_MMA(1, 0, At, B0); PG8_MMA(1, 1, At, B1); PG8_BAR; PG8_SCHED;
            PG8_LDB(B0, 1, 0); PG8_LDB(B1, 1, 1); PG8_SCHED; PG8_LDA(At, 1, 0); PG8_STAGE(PG8_SA(0, 1), a2 + hstepA, voffA);
            PG8_WAIT_V(8); PG8_WAIT_L(0); PG8_BAR; PG8_MMA(0, 0, At, B0); PG8_MMA(0, 1, At, B1); PG8_BAR; PG8_SCHED;
            PG8_LDA(At, 1, 1); PG8_STAGE(PG8_SB(1, 0), b3, voffB); PG8_STAGE(PG8_SB(1, 1), b3 + hstep, voffB); PG8_STAGE(PG8_SA(1, 0), a3, voffA);
            PG8_WAIT_V(8); PG8_WAIT_L(0); PG8_BAR; PG8_MMA(1, 0, At, B0); PG8_MMA(1, 1, At, B1); PG8_BAR; PG8_SCHED;
            } else {
            PG8_LDB(B0, 0, 0); PG8_SCHED; PG8_LDA(At, 0, 0); PG8_STAGE(PG8_SA(1, 1), a1 + hstepA, voffA);
            PG8_WAIT_L(8); PG8_BAR; PG8_WAIT_L(0); PG8_MMA(0, 0, At, B0); PG8_BAR; PG8_SCHED;
            PG8_LDB(B1, 0, 1); PG8_STAGE(PG8_SB(0, 0), b2, voffB);
            PG8_BAR; PG8_WAIT_L(0); PG8_MMA(0, 1, At, B1); PG8_BAR;
            PG8_LDA(At, 0, 1); PG8_STAGE(PG8_SA(0, 0), a2, voffA);
            PG8_BAR; PG8_WAIT_L(0); PG8_MMA(1, 0, At, B0); PG8_BAR; PG8_SCHED;
            PG8_STAGE(PG8_SB(0, 1), b2 + hstep, voffB);
            PG8_WAIT_V(6); PG8_BAR; PG8_MMA(1, 1, At, B1); PG8_BAR;
            PG8_LDB(B0, 1, 0); PG8_SCHED; PG8_LDA(At, 1, 0); PG8_STAGE(PG8_SA(0, 1), a2 + hstepA, voffA);
            PG8_WAIT_L(8); PG8_BAR; PG8_WAIT_L(0); PG8_MMA(0, 0, At, B0); PG8_BAR; PG8_SCHED;
            PG8_LDB(B1, 1, 1); PG8_STAGE(PG8_SB(1, 0), b3, voffB);
            PG8_BAR; PG8_WAIT_L(0); PG8_MMA(0, 1, At, B1); PG8_BAR;
            PG8_LDA(At, 1, 1); PG8_STAGE(PG8_SA(1, 0), a3, voffA);
            PG8_BAR; PG8_WAIT_L(0); PG8_MMA(1, 0, At, B0); PG8_BAR; PG8_SCHED;
            PG8_STAGE(PG8_SB(1, 1), b3 + hstep, voffB);
            PG8_WAIT_V(6); PG8_BAR; PG8_MMA(1, 1, At, B1); PG8_BAR;
            }
        }
        if constexpr (ALIGN_EPI) { if (wr == 0) PG8_BAR; }
        if constexpr (!Epi::AFTER_DRAIN) { E(acc, cur, wr, wc, fr, fq); S.done(cur); }
        if (!has_next) break;
#pragma unroll
        for (int a = 0; a < 2; ++a)
#pragma unroll
            for (int b = 0; b < 2; ++b)
#pragma unroll
                for (int m = 0; m < 4; ++m)
#pragma unroll
                    for (int n = 0; n < 2; ++n) acc[a][b][m][n] = (f32x4){0.f, 0.f, 0.f, 0.f};
        cur = nxt; cA = nA; cB = nB; ++ui;
        if constexpr (ALIGN_EPI) { if (wr == 1) PG8_BAR; }
    }
    PG8_WAIT_V(0);
    if constexpr (!ALIGN_EPI) { if (wr == 0) PG8_BAR; }
    PG8_BAR;
    if constexpr (Epi::AFTER_DRAIN) { E.fused(acc, cur, wr, wc, fr, fq, lds, wid, lane); S.done(cur); }
#undef PG8_SA
#undef PG8_SB
#undef PG8_STAGE
#undef PG8_LDA
#undef PG8_LDB
#undef PG8_MMA
#undef PG8_WAIT_V
#undef PG8_WAIT_L
#undef PG8_BAR
#undef PG8_SCHED
}
}
typedef unsigned u32x4 __attribute__((ext_vector_type(4)));
#define GAS __attribute__((address_space(1)))
#define LAS __attribute__((address_space(3)))
typedef unsigned short bf16;
typedef unsigned v4u __attribute__((ext_vector_type(4)));
typedef unsigned u32x2 __attribute__((ext_vector_type(2)));
typedef float f32x4 __attribute__((ext_vector_type(4)));
typedef short bf16x8 __attribute__((ext_vector_type(8)));
typedef GAS unsigned gu32;
typedef GAS unsigned long long gu64;
#define RLX_AGENT __ATOMIC_RELAXED, __HIP_MEMORY_SCOPE_AGENT
#define LDS_WAIT() asm volatile("s_waitcnt lgkmcnt(0)" ::: "memory")
#define VM_WAIT() asm volatile("s_waitcnt vmcnt(0)" ::: "memory")
__device__ __forceinline__ unsigned long long rt() { return __builtin_amdgcn_s_memrealtime(); }
__device__ __forceinline__ unsigned f2bf(float f) { return (unsigned)__builtin_bit_cast(unsigned short, (__bf16)f); }
typedef float f32x2_c __attribute__((ext_vector_type(2))); typedef __bf16 bf16x2_c __attribute__((ext_vector_type(2)));
__device__ __forceinline__ unsigned pk2(float lo, float hi) { const f32x2_c v = {lo, hi}; return __builtin_bit_cast(unsigned, __builtin_convertvector(v, bf16x2_c)); }

#define XB_TMO      128
#define XB_XCNT(j)  (256  + 64 * (j))
#define XB_XSUB(j)  (1280 + 64 * (j))
#define XB_XGEN(j)  (2304 + 64 * (j))
#define XB_TOP      3328
#define XB_TOPGEN   3392
#define XCD_BAR_WORDS 3456
#define XB_SPIN_CAP (1u << 20)

__device__ __forceinline__ unsigned xb_ld(unsigned* p)              { return __hip_atomic_load(p, __ATOMIC_RELAXED, __HIP_MEMORY_SCOPE_AGENT); }
__device__ __forceinline__ unsigned xb_add(unsigned* p, unsigned v) { return __hip_atomic_fetch_add(p, v, __ATOMIC_RELAXED, __HIP_MEMORY_SCOPE_AGENT); }
__device__ __forceinline__ unsigned xb_xcc_id() { return (unsigned)__builtin_amdgcn_s_getreg((3 << 11) | 20) & 0xFu; }
#define XB_SPIN(cond, bar) do { unsigned _sp = 0; while (cond) { __builtin_amdgcn_s_sleep(1); \
    if ((++_sp & 255u) == 0u) { if (xb_ld(&(bar)[XB_TMO])) break; if (_sp > XB_SPIN_CAP) { atomicAdd(&(bar)[XB_TMO], 1u); break; } } } } while (0)

struct XcdBarrier {
    unsigned* bar; unsigned x; int wv;
    volatile LAS unsigned* st;
};

__device__ __forceinline__ XcdBarrier xcd_barrier_post(unsigned* bar, volatile LAS unsigned* st) {
    XcdBarrier b; b.bar = bar; b.x = (unsigned)__builtin_amdgcn_readfirstlane((int)xb_xcc_id()); b.st = st;
    if (threadIdx.x == 0) (void)xb_add(&bar[XB_XCNT(b.x)], 1u);
    return b;
}
__device__ __forceinline__ void xcd_barrier_complete(unsigned* bar, unsigned x, unsigned& nloc, unsigned& nx) {
    const unsigned G = gridDim.x * gridDim.y * gridDim.z;
    unsigned sum, cnt, mine, sp = 0u;
    for (;;) {
        sum = 0u; cnt = 0u; mine = 0u;
#pragma unroll
        for (unsigned j = 0; j < 16; ++j) { const unsigned c = xb_ld(&bar[XB_XCNT(j)]); sum += c; cnt += (c > 0u) ? 1u : 0u; mine = (j == x) ? c : mine; }
        if (sum == G) break;
        __builtin_amdgcn_s_sleep(1);
        if ((++sp & 255u) == 0u) { if (xb_ld(&bar[XB_TMO])) break; if (sp > XB_SPIN_CAP) { atomicAdd(&bar[XB_TMO], 1u); break; } }
    }
    nloc = mine > 0u ? mine : 1u; nx = cnt > 0u ? cnt : 1u;
}

__device__ __forceinline__ void xcd_barrier(const XcdBarrier& b) {
    asm volatile("s_waitcnt vmcnt(0)" ::: "memory");
    __syncthreads();
    if (b.wv == 0 && LANE_ID() == 0) {
        unsigned* bar = b.bar;
        __builtin_amdgcn_s_waitcnt(0);
        unsigned nloc = b.st[0], nx = b.st[1];
        if (nloc == 0u) { xcd_barrier_complete(bar, b.x, nloc, nx); b.st[0] = nloc; b.st[1] = nx; }
        const unsigned old = xb_add(&bar[XB_XSUB(b.x)], 1u);
        const unsigned gen = old / nloc;
        if (old + 1u == (gen + 1u) * nloc) {
            __builtin_amdgcn_fence(__ATOMIC_RELEASE, "agent");
            asm volatile("s_waitcnt vmcnt(0)" ::: "memory");
            const unsigned og = xb_add(&bar[XB_TOP], 1u);
            const unsigned tg = og / nx;
            if (og + 1u == (tg + 1u) * nx) xb_add(&bar[XB_TOPGEN], 1u);
            else XB_SPIN(xb_ld(&bar[XB_TOPGEN]) == tg, bar);
            __builtin_amdgcn_fence(__ATOMIC_ACQUIRE, "agent");
            xb_add(&bar[XB_XGEN(b.x)], 1u);
            asm volatile("s_waitcnt vmcnt(0)" ::: "memory");
        } else {
            XB_SPIN(xb_ld(&bar[XB_XGEN(b.x)]) == gen, bar);
            __builtin_amdgcn_fence(__ATOMIC_ACQUIRE, "agent");
            asm volatile("s_waitcnt vmcnt(0)" ::: "memory");
        }
    }
    __syncthreads();
}
__device__ __forceinline__ void xcd_split_arrive(const XcdBarrier& b, unsigned* sb, unsigned round) {
    asm volatile("s_waitcnt vmcnt(0)" ::: "memory");
    __syncthreads();
    if (b.wv == 0 && LANE_ID() == 0) {
        __builtin_amdgcn_s_waitcnt(0);
        const unsigned nloc = b.st[0], nx = b.st[1];
        const unsigned old = xb_add(&sb[XB_XSUB(b.x)], 1u);
        if (old + 1u == (round + 1u) * nloc) {
            __builtin_amdgcn_fence(__ATOMIC_RELEASE, "agent");
            asm volatile("s_waitcnt vmcnt(0)" ::: "memory");
            const unsigned og = xb_add(&sb[XB_TOP], 1u);
            if (og + 1u == (round + 1u) * nx) xb_add(&sb[XB_TOPGEN], 1u);
        }
    }
}
__device__ __forceinline__ void xcd_split_wait(const XcdBarrier& b, unsigned* sb, unsigned round) {
    if (b.wv == 0 && LANE_ID() == 0) {
        XB_SPIN(xb_ld(&sb[XB_TOPGEN]) <= round, b.bar);
        __builtin_amdgcn_fence(__ATOMIC_ACQUIRE, "agent");
        asm volatile("s_waitcnt vmcnt(0)" ::: "memory");
    }
    __syncthreads();
}
constexpr int NWAVES = 8;
constexpr int BATCH = 8, SEQ = 8192, D = 1024, M = BATCH * SEQ, NL = 4, PIN = 3472, PINP = 3584, FF = 4096;
constexpr int SA0 = 0, SB0 = 768, SC0 = 1552, SD0 = 2576;
constexpr float LOG2E = 1.4426950408889634f;
constexpr size_t MiB = 1u << 20;
constexpr size_t WS_CTL = 0, CTL_ZERO_BYTES = 65536;
constexpr size_t WS_LC = 1 * MiB;
constexpr size_t WS_LB = 1 * MiB + 65536;
constexpr size_t WS_BS = 2 * MiB;
constexpr size_t WS_ZG = 4 * MiB;
constexpr size_t WS_WI = 20 * MiB, WS_WO = 48 * MiB, WS_WU = 56 * MiB, WS_WD = 88 * MiB;
constexpr size_t WS_PR = 120 * MiB;
constexpr size_t WS_SC = 568 * MiB;
constexpr size_t WS_X2 = 856 * MiB;
constexpr size_t WS_H = 120 * MiB;
constexpr size_t WS_SS = 984 * MiB;
constexpr size_t WS_END = 1020 * MiB;
constexpr size_t SC_RWS = 0, SC_HS = 160 * MiB, SC_GS = 224 * MiB;
constexpr int CW_TMO = 0, CW_CODE = 1, CW_BAR = 4096, CW_SBAR = 8192;
constexpr int RING_OFF = 0, RING_BYTES = 131072;
constexpr int LDSCTL_OFF = RING_BYTES, MISC_OFF = LDSCTL_OFF + 320;
constexpr int LDS_BYTES = 147456;
typedef float f32x16 __attribute__((ext_vector_type(16)));
typedef short s16x4 __attribute__((ext_vector_type(4)));
struct Args { const float* in[30]; float* out; unsigned char* ws; };
struct Frame {
    LAS unsigned char* lds;
    volatile LAS unsigned* MISC;
    gu32* ctl;
    int tid, lane, wave;
    int vcu, G;
    float* out; unsigned char* ws;
};
#define LDS_BAR() asm volatile("s_waitcnt lgkmcnt(0)\n\ts_barrier" ::: "memory")
__device__ __forceinline__ int lane_id() { return LANE_ID(); }
__device__ __forceinline__ int crow32(int r, int hi) { return (r & 3) + 8 * (r >> 2) + 4 * hi; }
__device__ __forceinline__ float bf2f(unsigned short b) { return __builtin_bit_cast(float, (unsigned)b << 16); }
template <int CTRL> __device__ __forceinline__ float dppf(float v) { return __builtin_bit_cast(float, __builtin_amdgcn_update_dpp(0, __builtin_bit_cast(int, v), CTRL, 0xf, 0xf, true)); }
__device__ __forceinline__ float wave_sum(float v) {
    v += dppf<0xB1>(v); v += dppf<0x4E>(v); v += dppf<0x141>(v); v += dppf<0x140>(v);
    { auto r = __builtin_amdgcn_permlane16_swap(__float_as_uint(v), __float_as_uint(v), false, false); v = __uint_as_float(r[0]) + __uint_as_float(r[1]); }
    { auto r = __builtin_amdgcn_permlane32_swap(__float_as_uint(v), __float_as_uint(v), false, false); v = __uint_as_float(r[0]) + __uint_as_float(r[1]); }
    return v;
}
__device__ __forceinline__ float wave_max(float v) {
#pragma unroll
    for (int o = 1; o < 64; o <<= 1) v = fmaxf(v, __shfl_xor(v, o));
    return v;
}
__device__ __forceinline__ float sigmoidf_(float x) { return __builtin_amdgcn_rcpf(1.f + __expf(-x)); }

__device__ __forceinline__ void p0_transpose_item(const float* W, int K, int N, int NP, bf16* WT, LAS float* scr, int item, int lane, const float* gain = nullptr) {
    const int nblk = NP / 32, kb = item / nblk, nb = item % nblk, k0 = 64 * kb, n0 = 32 * nb;
    const int ncol = n0 + (lane & 31);
#pragma unroll 8
    for (int i = 0; i < 32; ++i) { const int kk = 2 * i + (lane >> 5); scr[kk * 33 + (lane & 31)] = (ncol < N) ? W[(size_t)(k0 + kk) * N + ncol] * (gain ? gain[k0 + kk] : 1.f) : 0.f; }
    LDS_WAIT(); asm volatile("" ::: "memory");
    const int c = lane & 7;
#pragma unroll
    for (int j = 0; j < 4; ++j) { const int n = (lane >> 3) + 8 * j; const LAS float* s = scr + (8 * c) * 33 + n;
        v4u o; o.x = pk2(s[0 * 33], s[1 * 33]); o.y = pk2(s[2 * 33], s[3 * 33]); o.z = pk2(s[4 * 33], s[5 * 33]); o.w = pk2(s[6 * 33], s[7 * 33]);
        *(GAS v4u*)(WT + (size_t)(n0 + n) * K + k0 + 8 * c) = o; }
    LDS_WAIT(); asm volatile("" ::: "memory");
}
__device__ __forceinline__ void p0_prologue(Frame& F, const Args& A) {
    LAS float* scr = (LAS float*)(F.lds + RING_OFF + F.wave * 16384);
    const int gw = F.vcu * NWAVES + F.wave, NGW = F.G * NWAVES;
    constexpr int I_I = (D / 64) * (PINP / 32), I_O = (D / 64) * (D / 32), I_U = (D / 64) * (FF / 32), I_D = (FF / 64) * (D / 32);
    constexpr int PER_L = I_I + I_O + I_U + I_D;
    for (int it = gw; it < NL * PER_L; it += NGW) {
        const int l = it / PER_L; int r = it % PER_L;
        if (r < I_I) { p0_transpose_item(A.in[2] + (size_t)l * D * PIN, D, PIN, PINP, (bf16*)(F.ws + WS_WI) + (size_t)l * PINP * D, scr, r, F.lane, A.in[1] + l * D); continue; } r -= I_I;
        if (r < I_O) { p0_transpose_item(A.in[26] + (size_t)l * D * D, D, D, D, (bf16*)(F.ws + WS_WO) + (size_t)l * D * D, scr, r, F.lane); continue; } r -= I_O;
        if (r < I_U) { p0_transpose_item(A.in[28] + (size_t)l * D * FF, D, FF, FF, (bf16*)(F.ws + WS_WU) + (size_t)l * FF * D, scr, r, F.lane, A.in[27] + l * D); continue; } r -= I_U;
        p0_transpose_item(A.in[29] + (size_t)l * FF * D, FF, D, D, (bf16*)(F.ws + WS_WD) + (size_t)l * D * FF, scr, r, F.lane);
    }
    if (blockIdx.x == 0 && F.wave == 0) {
        for (int l = 0; l < NL; ++l) {
            const int i = F.lane & 31; const bool on = F.lane < 32;
            const float s1 = wave_sum(on ? A.in[5][l * 32 + i] * A.in[6][l * 32 + i] : 0.f);
            const float s2 = wave_sum(on ? A.in[7][l * 32 + i] * A.in[8][l * 32 + i] : 0.f);
            const float gq = wave_max(fabsf(A.in[3][l * 32 + i])), gk = wave_max(fabsf(A.in[4][l * 32 + i]));
            const float lam_init = 0.8f - 0.6f * expf(-0.3f * (float)l);
            if (F.lane == 0) { ((float*)(F.ws + WS_LC))[l * 16 + 0] = expf(s1) - expf(s2) + lam_init; ((float*)(F.ws + WS_LC))[l * 16 + 1] = lam_init; ((float*)(F.ws + WS_LC))[l * 16 + 2] = LOG2E * 5.656854249f * gq * gk; }
        }
    }
    if (blockIdx.x == 0 && F.wave >= 1 && F.wave <= 4) {
        const int c = (F.wave - 1) * 64 + F.lane;
        float z[NL], mx = -1e30f, sum = 0.f;
        for (int l = 0; l < NL; ++l) { z[l] = A.in[13][l * 256 + c]; mx = fmaxf(mx, z[l]); }
        for (int l = 0; l < NL; ++l) { z[l] = expf(z[l] - mx); sum += z[l]; }
        float cum = 0.f;
        for (int l = 0; l < NL; ++l) { if (l > 0) cum += z[l] / sum; ((float*)(F.ws + WS_LB))[l * 256 + c] = cum; }
    }
}
__device__ __forceinline__ void x0_phase(Frame& F, const float* src, bf16* dst, float* ss) {
    const int gw = F.vcu * NWAVES + F.wave, NGW = F.G * NWAVES;
    for (int m = gw; m < M; m += NGW) {
        const GAS f32x4* xr = (const GAS f32x4*)(src + (size_t)m * D) + F.lane;
        f32x4 v[4]; float s = 0.f;
#pragma unroll
        for (int j = 0; j < 4; ++j) { v[j] = xr[64 * j]; s += (v[j].x * v[j].x + v[j].y * v[j].y) + (v[j].z * v[j].z + v[j].w * v[j].w); }
        s = wave_sum(s);
        GAS unsigned long long* o8 = (GAS unsigned long long*)(dst + (size_t)m * D) + F.lane;
#pragma unroll
        for (int j = 0; j < 4; ++j) o8[64 * j] = (unsigned long long)pk2(v[j].x, v[j].y) | ((unsigned long long)pk2(v[j].z, v[j].w) << 32);
        if (F.lane < 16) ss[(size_t)m * 16 + F.lane] = (F.lane == 0) ? s : 0.f;
    }
}
__device__ __forceinline__ void prep_attn(Frame& F, const Args& A, int l) {
    const int gw = F.vcu * NWAVES + F.wave, NGW = F.G * NWAVES;
    float g8[8];
    { const float* gsrc = (F.lane < 32 ? A.in[3] : A.in[4]) + l * 32 + (F.lane & 3) * 8; const float sc = F.lane < 32 ? 0.17677669529663687f * LOG2E : 1.f;
#pragma unroll
      for (int i = 0; i < 8; ++i) g8[i] = gsrc[i] * sc; }
    for (int m0 = gw; m0 < M; m0 += 4 * NGW) {
        v4u raw4[4];
#pragma unroll
        for (int u = 0; u < 4; ++u) raw4[u] = (m0 + u * NGW < M) ? *((GAS v4u*)(((bf16*)(F.ws + WS_PR)) + (size_t)(m0 + u * NGW) * PINP + SA0) + F.lane) : (v4u){0u, 0u, 0u, 0u};
#pragma unroll
        for (int u = 0; u < 4; ++u) {
            const v4u raw = raw4[u]; float v[8];
#pragma unroll
            for (int i = 0; i < 4; ++i) { v[2 * i] = __builtin_bit_cast(float, raw[i] << 16); v[2 * i + 1] = __builtin_bit_cast(float, raw[i] & 0xffff0000u); }
            float s = 0.f;
#pragma unroll
            for (int i = 0; i < 8; ++i) s += v[i] * v[i];
            s += dppf<0xB1>(s); s += dppf<0x4E>(s);
            const float rs = rsqrtf(s * (1.f / 32.f) + 1e-6f);
            v4u o;
#pragma unroll
            for (int i = 0; i < 4; ++i) o[i] = pk2(v[2 * i] * rs * g8[2 * i], v[2 * i + 1] * rs * g8[2 * i + 1]);
            if (m0 + u * NGW < M) *((GAS v4u*)(((bf16*)(F.ws + WS_PR)) + (size_t)(m0 + u * NGW) * PINP + SA0) + F.lane) = o;
        }
    }
}
__device__ __forceinline__ void prep_scalars(Frame& F, const Args& A, int l) {
    LAS unsigned char* lrb = F.lds + RING_OFF;
    LAS unsigned char* gdb = F.lds + RING_OFF + 4608;
    LAS float* xwl = (LAS float*)(F.lds + RING_OFF + 8192);
    LAS float* xal = xwl + 32 * 256;
    LAS float* gxl = xal + 32 * 256;
    bf16* RWS = (bf16*)(F.ws + WS_SC + SC_RWS); bf16* HS = (bf16*)(F.ws + WS_SC + SC_HS); bf16* GS = (bf16*)(F.ws + WS_SC + SC_GS);
    const int tid = F.tid, c = tid & 255, th = __builtin_amdgcn_readfirstlane(tid >> 8), h = __builtin_amdgcn_readfirstlane(c >> 6), lane = F.lane;
    const float* mu = A.in[15] + l * 896;
    const float mu_r = mu[c], mu_k = mu[256 + c], w0c = A.in[16][l * 256 + c], a0c = A.in[18][l * 256 + c], kkc = A.in[21][l * 256 + c], kac = A.in[22][l * 256 + c], rkc = A.in[23][l * 256 + c];
    const float lbc = ((float*)(F.ws + WS_LB))[l * 256 + c];
    const int r32 = lane & 31, hi = lane >> 5, wv = F.wave;
    bf16x8 bw[2], ba[2], bg;
#pragma unroll
    for (int kk = 0; kk < 2; ++kk)
#pragma unroll
        for (int i = 0; i < 8; ++i) { const int j = 16 * kk + 8 * hi + i; bw[kk][i] = (short)f2bf(A.in[17][(l * 32 + j) * 256 + 32 * wv + r32]); ba[kk][i] = (short)f2bf(A.in[19][(l * 32 + j) * 256 + 32 * wv + r32]); }
#pragma unroll
    for (int i = 0; i < 8; ++i) bg[i] = (short)f2bf(A.in[10][(l * 16 + 8 * hi + i) * 128 + 32 * (wv & 3) + r32]);
    const int c2 = tid & 127, tq = __builtin_amdgcn_readfirstlane(tid >> 7), h2 = c2 >> 5;
    const float gb = A.in[11][l * 128 + c2];
    const int c4 = 4 * lane, hl = lane >> 4, cw = c4 & 63, c4g = 4 * (lane & 31), tsub = lane >> 5, h2g = c4g >> 5;
    const f32x4 mur4 = *(const f32x4*)(mu + c4), muk4 = *(const f32x4*)(mu + 256 + c4), w04 = *(const f32x4*)(A.in[16] + l * 256 + c4), a04 = *(const f32x4*)(A.in[18] + l * 256 + c4),
                kkc4 = *(const f32x4*)(A.in[21] + l * 256 + c4), kac4 = *(const f32x4*)(A.in[22] + l * 256 + c4), rkc4 = *(const f32x4*)(A.in[23] + l * 256 + c4),
                lb4 = *(const f32x4*)((float*)(F.ws + WS_LB) + l * 256 + c4), gb4 = *(const f32x4*)(A.in[11] + l * 128 + c4g);
    bf16 s1r[4], s1p[4], s1g;
    u32x2 i_rr[4], i_kr[4], i_rp[4], i_kp[4], i_hq[4], i_hz[4], i_gq[2], i_gk[2];
#define PS_HEAD(M0) do { const int m0_ = (M0), t0_ = m0_ % SEQ; \
        _Pragma("unroll") for (int e = 0; e < 4; ++e) { const int idx = tid * 4 + e, i = idx >> 6, j = idx & 63; const size_t m = (size_t)m0_ + i; \
            s1r[e] = ((bf16*)(F.ws + WS_PR))[m * PINP + SD0 + 768 + j]; s1p[e] = ((bf16*)(F.ws + WS_PR))[(m - (t0_ + i > 0 ? 1 : 0)) * PINP + SD0 + 768 + j]; } \
        s1g = ((bf16*)(F.ws + WS_PR))[((size_t)m0_ + (tid >> 4)) * PINP + SB0 + 512 + (tid & 15)]; } while (0)
#define PS_LOADT(k, M0) do { const int tok_ = 4 * wv + (k), t_ = (M0) % SEQ + tok_; const bf16* row = ((bf16*)(F.ws + WS_PR)) + ((size_t)(M0) + tok_) * PINP + c4; const bf16* rowp = row - (t_ > 0 ? PINP : 0); \
        i_rr[k] = *(const u32x2*)(row + SD0); i_kr[k] = *(const u32x2*)(row + SD0 + 256); i_rp[k] = *(const u32x2*)(rowp + SD0); i_kp[k] = *(const u32x2*)(rowp + SD0 + 256); \
        i_hq[k] = *(const u32x2*)(row + SC0); i_hz[k] = *(const u32x2*)(row + SC0 + 256); } while (0)
#define PG_LOADT(q, M0) do { const bf16* row = ((bf16*)(F.ws + WS_PR)) + ((size_t)(M0) + 4 * wv + 2 * (q) + tsub) * PINP + SB0 + c4g; i_gq[q] = *(const u32x2*)row; i_gk[q] = *(const u32x2*)(row + 128); } while (0)
#define BF4(v, o) do { o[0] = __builtin_bit_cast(float, (v).x << 16); o[1] = __builtin_bit_cast(float, (v).x & 0xffff0000u); o[2] = __builtin_bit_cast(float, (v).y << 16); o[3] = __builtin_bit_cast(float, (v).y & 0xffff0000u); } while (0)
#define ROW16(v) do { v += dppf<0xB1>(v); v += dppf<0x4E>(v); v += dppf<0x141>(v); v += dppf<0x140>(v); } while (0)
    if (F.vcu < M / 32) { PS_HEAD(F.vcu * 32);
#pragma unroll
        for (int k = 0; k < 4; ++k) PS_LOADT(k, F.vcu * 32);
        PG_LOADT(0, F.vcu * 32); PG_LOADT(1, F.vcu * 32); }
#define PS_STAGE1(M0) do { const int t0s_ = (M0) % SEQ; \
        _Pragma("unroll") for (int e = 0; e < 4; ++e) { const int idx = tid * 4 + e, i = idx >> 6, j = idx & 63; \
            const float raw = bf2f(s1r[e]); const float prev = (t0s_ + i > 0) ? bf2f(s1p[e]) : 0.f; \
            float val = raw + mu[768 + j] * (prev - raw); if (j < 32) val = tanhf(val); *(LAS bf16*)(lrb + i * 144 + j * 2) = (bf16)f2bf(val); } \
        { const int i = tid >> 4, j = tid & 15; *(LAS bf16*)(gdb + i * 48 + j * 2) = s1g; } } while (0)
    if (F.vcu < M / 32) PS_STAGE1(F.vcu * 32);
    for (int u = F.vcu; u < M / 32; u += F.G) {
        const int m0 = u * 32, bl = m0 / SEQ, t0 = m0 % SEQ;
        LDS_BAR();
        {
            f32x16 cw_ = {}, ca = {};
#pragma unroll
            for (int kk = 0; kk < 2; ++kk) {
                const bf16x8 aw = *(const LAS bf16x8*)(lrb + r32 * 144 + (16 * kk + 8 * hi) * 2), aa = *(const LAS bf16x8*)(lrb + r32 * 144 + (32 + 16 * kk + 8 * hi) * 2);
                cw_ = __builtin_amdgcn_mfma_f32_32x32x16_bf16(aw, bw[kk], cw_, 0, 0, 0); ca = __builtin_amdgcn_mfma_f32_32x32x16_bf16(aa, ba[kk], ca, 0, 0, 0); }
#pragma unroll
            for (int r = 0; r < 16; ++r) { const int tok = crow32(r, hi); xwl[tok * 256 + 32 * wv + r32] = cw_[r]; xal[tok * 256 + 32 * wv + r32] = ca[r]; }
            if (wv < 4) { f32x16 cg = {}; const bf16x8 ag = *(const LAS bf16x8*)(gdb + r32 * 48 + 8 * hi * 2);
                cg = __builtin_amdgcn_mfma_f32_32x32x16_bf16(ag, bg, cg, 0, 0, 0);
#pragma unroll
                for (int r = 0; r < 16; ++r) gxl[crow32(r, hi) * 128 + 32 * wv + r32] = cg[r]; }
        }
        LDS_BAR();
        const int un = (u + F.G < M / 32) ? u + F.G : u;
        PS_HEAD(un * 32);
#pragma unroll
        for (int k = 0; k < 4; ++k) {
            const int tok = 4 * wv + k, t = t0 + tok; const size_t m = (size_t)m0 + tok;
            float rr[4], kr[4], rp[4], kp[4], hq[4], hz[4];
            BF4(i_rr[k], rr); BF4(i_kr[k], kr); BF4(i_rp[k], rp); BF4(i_kp[k], kp); BF4(i_hq[k], hq); BF4(i_hz[k], hz);
            const f32x4 xw4 = *(const LAS f32x4*)(xwl + tok * 256 + c4), xa4 = *(const LAS f32x4*)(xal + tok * 256 + c4);
            float r[4], kv[4], kk[4], av[4], wv_[4], k2[4];
#pragma unroll
            for (int e = 0; e < 4; ++e) {
                const float rpv = (t > 0) ? rp[e] : 0.f, kpv = (t > 0) ? kp[e] : 0.f;
                r[e] = rr[e] + mur4[e] * (rpv - rr[e]); kv[e] = kr[e] + muk4[e] * (kpv - kr[e]);
                wv_[e] = __expf(-0.606531f * sigmoidf_(w04[e] + xw4[e])); av[e] = sigmoidf_(a04[e] + xa4[e]);
                kk[e] = kv[e] * kkc4[e]; k2[e] = kv[e] * (1.f + (av[e] - 1.f) * kac4[e]); }
            float ss = (kk[0] * kk[0] + kk[1] * kk[1]) + (kk[2] * kk[2] + kk[3] * kk[3]);
            float bs = (r[0] * k2[0] * rkc4[0] + r[1] * k2[1] * rkc4[1]) + (r[2] * k2[2] * rkc4[2] + r[3] * k2[3] * rkc4[3]);
            ROW16(ss); ROW16(bs);
            const float rn = rsqrtf(fmaxf(ss, 1e-24f));
            if ((lane & 15) == 0) ((float*)(F.ws + WS_BS))[m * 4 + hl] = bs;
            float kn[4];
#pragma unroll
            for (int e = 0; e < 4; ++e) kn[e] = kk[e] * rn;
            bf16* dst = RWS + (size_t)((bl * 4 + hl) * SEQ + t) * 320 + cw;
            u32x2 w;
            w.x = pk2(-kn[0], -kn[1]); w.y = pk2(-kn[2], -kn[3]); *(u32x2*)dst = w;
            w.x = pk2(1.f - wv_[0], 1.f - wv_[1]); w.y = pk2(1.f - wv_[2], 1.f - wv_[3]); *(u32x2*)(dst + 64) = w;
            w.x = pk2(kn[0] * av[0], kn[1] * av[1]); w.y = pk2(kn[2] * av[2], kn[3] * av[3]); *(u32x2*)(dst + 128) = w;
            w.x = pk2(k2[0], k2[1]); w.y = pk2(k2[2], k2[3]); *(u32x2*)(dst + 192) = w;
            w.x = pk2(r[0], r[1]); w.y = pk2(r[2], r[3]); *(u32x2*)(dst + 256) = w;
            bf16* hd = HS + (size_t)((bl * 4 + hl) * SEQ + t) * 128 + cw;
            w.x = pk2(hq[0] * sigmoidf_(hq[0]), hq[1] * sigmoidf_(hq[1])); w.y = pk2(hq[2] * sigmoidf_(hq[2]), hq[3] * sigmoidf_(hq[3])); *(u32x2*)hd = w;
            w.x = pk2((1.f - lb4[0]) * sigmoidf_(-hz[0]), (1.f - lb4[1]) * sigmoidf_(-hz[1])); w.y = pk2((1.f - lb4[2]) * sigmoidf_(-hz[2]), (1.f - lb4[3]) * sigmoidf_(-hz[3])); *(u32x2*)(hd + 64) = w;
            PS_LOADT(k, un * 32);
        }
#pragma unroll
        for (int q = 0; q < 2; ++q) {
            const int tok = 4 * wv + 2 * q + tsub, t = t0 + tok;
            float gq[4], gk[4]; BF4(i_gq[q], gq); BF4(i_gk[q], gk);
            const f32x4 gx4 = *(const LAS f32x4*)(gxl + tok * 128 + c4g);
            float od[4];
#pragma unroll
            for (int e = 0; e < 4; ++e) { const float x = gb4[e] + gx4[e];
                const float ls = (x < 0.f ? x : 0.f) - __logf(1.f + __expf(-fabsf(x)));
                od[e] = -expm1f(ls * (1.f / 16.f)); }
            bf16* gd = GS + (size_t)((bl * 4 + h2g) * SEQ + t) * 128 + (c4g & 31);
            u32x2 w;
            w.x = pk2(gq[0] * 0.17677669529663687f, gq[1] * 0.17677669529663687f); w.y = pk2(gq[2] * 0.17677669529663687f, gq[3] * 0.17677669529663687f); *(u32x2*)gd = w;
            *(u32x2*)(gd + 32) = i_gk[q];
            w.x = pk2(od[0], od[1]); w.y = pk2(od[2], od[3]); *(u32x2*)(gd + 64) = w;
            PG_LOADT(q, un * 32);
        }
        PS_STAGE1(un * 32);
    }
#undef PS_STAGE1
#undef PS_HEAD
#undef PS_LOADT
#undef PG_LOADT
#undef BF4
#undef ROW16
}
namespace att {
typedef __attribute__((address_space(3))) const char* lds_cptr;
typedef short v4i16_t __attribute__((ext_vector_type(4)));
typedef float f32x2_t __attribute__((ext_vector_type(2))); typedef __bf16 bf16x2_t __attribute__((ext_vector_type(2)));
constexpr int SLOTB = 8192, LDS_K = 0, LDS_V = 4 * SLOTB, LDS_WS = 8 * SLOTB, LDS_STG = 0, LDS_TOTAL = LDS_WS + 2048;
__device__ __forceinline__ int crow(int r, int hi) { return (r & 3) + 8 * (r >> 2) + 4 * hi; }
__device__ __forceinline__ void glds16(const void* gsrc, unsigned lds_dst) { unsigned keep;
    asm volatile("s_mov_b32 %0, m0\n\ts_mov_b32 m0, %2\n\ts_nop 0\n\tglobal_load_lds_dwordx4 %1, off\n\ts_mov_b32 m0, %0" : "=&s"(keep) : "v"(gsrc), "s"(lds_dst) : "memory"); }
__device__ __forceinline__ unsigned cvtpk_s(float lo, float hi) { f32x2_t v = {lo, hi}; bf16x2_t b = __builtin_convertvector(v, bf16x2_t); return __builtin_bit_cast(unsigned, b); }
__device__ __forceinline__ s16x4 vtr(lds_cptr p) { return __builtin_bit_cast(s16x4, __builtin_amdgcn_ds_read_tr16_b64_v4i16((__attribute__((address_space(3))) v4i16_t*)p)); }
#define ATT_WAIT_BAR() asm volatile("s_waitcnt vmcnt(0) lgkmcnt(0)\n\ts_barrier" ::: "memory")
__device__ __forceinline__ void attn_unit(int b, int h, int qb, bf16* PR, float lam, float ref2, float onemli, const float* gout, char* shm, int wave0) {
    int tid_ = wave0 * 64 + LANE_ID(); asm volatile("" : "+v"(tid_));
    const int tid = tid_, lane = tid & 63, r32 = lane & 31, hi = lane >> 5; const int wid = __builtin_amdgcn_readfirstlane(tid >> 6);
    const long rowbase = (long)b * SEQ; const int q0 = qb * 256;
    const bf16* Qw = PR + (rowbase + q0 + wid * 32) * PINP + SA0 + h * 64;
    const bf16* Kh = PR + rowbase * PINP + SA0 + 256 + h * 64; const bf16* Vh = PR + rowbase * PINP + SA0 + 512 + h * 64;
    const unsigned lds0 = (unsigned)(uintptr_t)shm;
    float* wsf = (float*)(shm + LDS_WS) + wid * 64;
    float* stg = (float*)(shm + LDS_STG) + wid * 2048;
    const bf16* ksrc = Kh + (long)lane * PINP + wid * 8;
    const bf16* vsrc = Vh + (long)(16 * (wid & 3) + (lane >> 2)) * PINP + (wid >> 2) * 32 + (lane & 3) * 8;
    const unsigned kdst = lds0 + LDS_K + wid * 1024, vdst = lds0 + LDS_V + wid * 1024;
#define DMA_K(t, slot) glds16(ksrc + (long)(t) * 64 * PINP, (unsigned)__builtin_amdgcn_readfirstlane(kdst + (slot)))
#define DMA_V(t, slot) glds16(vsrc + (long)(t) * 64 * PINP, (unsigned)__builtin_amdgcn_readfirstlane(vdst + (slot)))
    const lds_cptr shm3 = (lds_cptr)shm;
    const int NT = (q0 + 256) / 64;
    const float slope2 = LOG2E * exp2f(-2.f * (float)(h + 1));
    int t_lo = 0; { const float dmax = (2.f * ref2 + 150.f) / slope2; const float tl = ceilf(((float)(q0 - 63) - dmax) * (1.f / 64.f)); t_lo = tl > 0.f ? (int)tl : 0; t_lo = __builtin_amdgcn_readfirstlane(t_lo); }
    t_lo &= ~1;
    DMA_K(t_lo, ((t_lo >> 1) & 1) * 2 * SLOTB); DMA_V(t_lo, ((t_lo >> 1) & 1) * 2 * SLOTB); DMA_K(t_lo + 1, ((t_lo >> 1) & 1) * 2 * SLOTB + SLOTB); DMA_V(t_lo + 1, ((t_lo >> 1) & 1) * 2 * SLOTB + SLOTB);
    bf16x8 qr[4];
#pragma unroll
    for (int j = 0; j < 4; ++j) qr[j] = *reinterpret_cast<const bf16x8*>(&Qw[(long)r32 * PINP + j * 16 + hi * 8]);
    const int qpos = q0 + wid * 32 + r32;
    float cb[16];
#pragma unroll
    for (int r = 0; r < 16; ++r) cb[r] = slope2 * (float)crow(r, hi);
    float l1 = 0.f, l2 = 0.f; f32x16 o1[2], o2[2];
    o1[0] = f32x16{}; o1[1] = f32x16{}; o2[0] = f32x16{}; o2[1] = f32x16{};
#pragma unroll
    for (int j = 0; j < 4; ++j) asm volatile("" :: "v"(qr[j]));
    for (int tp = t_lo; tp < NT; tp += 2) {
        ATT_WAIT_BAR();
        if (tp + 2 < NT) { const int sn = (((tp + 2) >> 1) & 1) * 2 * SLOTB; DMA_K(tp + 2, sn); DMA_V(tp + 2, sn); DMA_K(tp + 3, sn + SLOTB); DMA_V(tp + 3, sn + SLOTB); }
#pragma unroll 1
      for (int tt = 0; tt < 2; ++tt) {
        const int t = tp + tt;
        const int slot = ((tp >> 1) & 1) * 2 * SLOTB + tt * SLOTB;
        if (64 * t <= q0 + wid * 32 + 31) {
            const lds_cptr kp = shm3 + LDS_K + slot + hi * 1024 + r32 * 16;
            bf16x8 kf[8];
#pragma unroll
            for (int j = 0; j < 4; ++j) { kf[2 * j] = *(const __attribute__((address_space(3))) bf16x8*)(kp + j * 2048); kf[2 * j + 1] = *(const __attribute__((address_space(3))) bf16x8*)(kp + j * 2048 + 512); }
            const float tc = slope2 * (float)(64 * t - qpos) - ref2;
            f32x16 c0, c1;
#pragma unroll
            for (int r = 0; r < 16; ++r) { c0[r] = cb[r] + tc; c1[r] = c0[r] + 32.f * slope2; }
            f32x16 pa0 = __builtin_amdgcn_mfma_f32_32x32x16_bf16(kf[0], qr[0], c0, 0, 0, 0); pa0 = __builtin_amdgcn_mfma_f32_32x32x16_bf16(kf[2], qr[1], pa0, 0, 0, 0);
            f32x16 pa1 = __builtin_amdgcn_mfma_f32_32x32x16_bf16(kf[1], qr[0], c1, 0, 0, 0); pa1 = __builtin_amdgcn_mfma_f32_32x32x16_bf16(kf[3], qr[1], pa1, 0, 0, 0);
            f32x16 pb0 = __builtin_amdgcn_mfma_f32_32x32x16_bf16(kf[4], qr[2], c0, 0, 0, 0); pb0 = __builtin_amdgcn_mfma_f32_32x32x16_bf16(kf[6], qr[3], pb0, 0, 0, 0);
            f32x16 pb1 = __builtin_amdgcn_mfma_f32_32x32x16_bf16(kf[5], qr[2], c1, 0, 0, 0); pb1 = __builtin_amdgcn_mfma_f32_32x32x16_bf16(kf[7], qr[3], pb1, 0, 0, 0);
#pragma unroll
            for (int r = 0; r < 16; ++r) { pa0[r] = __builtin_amdgcn_exp2f(pa0[r]); pa1[r] = __builtin_amdgcn_exp2f(pa1[r]); pb0[r] = __builtin_amdgcn_exp2f(pb0[r]); pb1[r] = __builtin_amdgcn_exp2f(pb1[r]); }
            if (64 * t + 63 > q0 + wid * 32) {
#pragma unroll
                for (int r = 0; r < 16; ++r) { const int kv = 64 * t + crow(r, hi);
                    if (kv > qpos) { pa0[r] = 0.f; pb0[r] = 0.f; }
                    if (kv + 32 > qpos) { pa1[r] = 0.f; pb1[r] = 0.f; } }
            }
            float sa = 0.f, sb = 0.f;
#pragma unroll
            for (int r = 0; r < 16; ++r) { sa += pa0[r] + pa1[r]; sb += pb0[r] + pb1[r]; }
            l1 += sa; l2 += sb;
            u32x4 pw[4], qw[4];
#pragma unroll
            for (int i = 0; i < 4; ++i) { pw[0][i] = cvtpk_s(pa0[2 * i], pa0[2 * i + 1]); pw[1][i] = cvtpk_s(pa0[8 + 2 * i], pa0[9 + 2 * i]); pw[2][i] = cvtpk_s(pa1[2 * i], pa1[2 * i + 1]); pw[3][i] = cvtpk_s(pa1[8 + 2 * i], pa1[9 + 2 * i]);
                qw[0][i] = cvtpk_s(pb0[2 * i], pb0[2 * i + 1]); qw[1][i] = cvtpk_s(pb0[8 + 2 * i], pb0[9 + 2 * i]); qw[2][i] = cvtpk_s(pb1[2 * i], pb1[2 * i + 1]); qw[3][i] = cvtpk_s(pb1[8 + 2 * i], pb1[9 + 2 * i]); }
            const lds_cptr vp = shm3 + LDS_V + slot + ((lane >> 4) & 1) * 32 + (lane & 3) * 8 + (4 * hi + ((lane & 15) >> 2)) * 64;
#pragma unroll
            for (int d0 = 0; d0 < 2; ++d0) {
#pragma unroll
                for (int k = 0; k < 4; ++k) {
                    const s16x4 vlo = vtr(vp + d0 * 4096 + k * 1024), vhi = vtr(vp + d0 * 4096 + k * 1024 + 512);
                    const bf16x8 vf = (bf16x8){vlo[0], vlo[1], vlo[2], vlo[3], vhi[0], vhi[1], vhi[2], vhi[3]};
                    o1[d0] = __builtin_amdgcn_mfma_f32_32x32x16_bf16(__builtin_bit_cast(bf16x8, pw[k]), vf, o1[d0], 0, 0, 0);
                    o2[d0] = __builtin_amdgcn_mfma_f32_32x32x16_bf16(__builtin_bit_cast(bf16x8, qw[k]), vf, o2[d0], 0, 0, 0);
                }
            }
        }
      }
    }
    ATT_WAIT_BAR();
    { auto r1 = __builtin_amdgcn_permlane32_swap(__float_as_uint(l1), __float_as_uint(l1), false, false); l1 = __uint_as_float(r1[0]) + __uint_as_float(r1[1]);
      auto r2 = __builtin_amdgcn_permlane32_swap(__float_as_uint(l2), __float_as_uint(l2), false, false); l2 = __uint_as_float(r2[0]) + __uint_as_float(r2[1]); }
    if (hi == 0) { wsf[r32] = 1.f / l1; wsf[32 + r32] = lam / l2; }
    asm volatile("s_waitcnt lgkmcnt(0)" ::: "memory");
#pragma unroll
    for (int r = 0; r < 16; ++r) { const int orow = crow(r, hi); const float a1 = wsf[orow], a2 = wsf[32 + orow];
#pragma unroll
        for (int d0 = 0; d0 < 2; ++d0) stg[orow * 64 + d0 * 32 + r32] = o1[d0][r] * a1 - o2[d0][r] * a2; }
    asm volatile("s_waitcnt lgkmcnt(0)" ::: "memory");
    bf16* Ow = PR + (rowbase + q0 + wid * 32) * PINP + SA0 + h * 64;
#pragma unroll
    for (int i = 0; i < 4; ++i) { const int row = i * 8 + (lane >> 3), ch = lane & 7;
        const f32x4 x0 = *(const f32x4*)(stg + row * 64 + ch * 8), x1 = *(const f32x4*)(stg + row * 64 + ch * 8 + 4);
        float s = (x0.x * x0.x + x0.y * x0.y) + (x0.z * x0.z + x0.w * x0.w) + (x1.x * x1.x + x1.y * x1.y) + (x1.z * x1.z + x1.w * x1.w);
        s += __shfl_xor(s, 1); s += __shfl_xor(s, 2); s += __shfl_xor(s, 4);
        const float rs = RS_EPS(s, 1.f / 64.f, 64e-6f) * onemli;
        const f32x4 g0 = *(const f32x4*)(gout + ch * 8), g1 = *(const f32x4*)(gout + ch * 8 + 4);
        u32x4 w; w.x = pk2(x0.x * rs * g0.x, x0.y * rs * g0.y); w.y = pk2(x0.z * rs * g0.z, x0.w * rs * g0.w); w.z = pk2(x1.x * rs * g1.x, x1.y * rs * g1.y); w.w = pk2(x1.z * rs * g1.z, x1.w * rs * g1.w);
        *(u32x4*)(Ow + (long)row * PINP + ch * 8) = w; }
    asm volatile("s_waitcnt lgkmcnt(0)\n\ts_barrier" ::: "memory");
#undef DMA_K
#undef DMA_V
}
}
__device__ __forceinline__ void attn_phase(Frame& F, const Args& A, int l, char* lds) {
    const float lam = ((float*)(F.ws + WS_LC))[l * 16 + 0], lam_init = ((float*)(F.ws + WS_LC))[l * 16 + 1], ref2 = ((float*)(F.ws + WS_LC))[l * 16 + 2];
    for (int v = F.vcu; v < 256; v += F.G) {
        const int b = v >> 5, s = v & 31;
        for (int i = 0; i < 4; ++i) {
            const int h = 3 - i, qb = (i & 1) ? 31 - s : s;
            att::attn_unit(b, h, qb, ((bf16*)(F.ws + WS_PR)), lam, ref2, 1.f - lam_init, A.in[9] + l * 64, lds, F.wave);
        }
    }
}
constexpr int NSR = 128, LR = SEQ / NSR, NSH = 64, LH = SEQ / NSH, NSG = 32, LG = SEQ / NSG;
constexpr size_t CRW_S = 0, CRW_P = 64 * MiB, CRW_T = 96 * MiB, CH_S = 128 * MiB, CH_T = 160 * MiB, CG_S = 176 * MiB, CG_T = 184 * MiB, CH_G = 188 * MiB, CG_G = 189 * MiB;
typedef float f32x2 __attribute__((ext_vector_type(2)));
#define PK_MUL(d, a, b) (d) = (a) * (b)
#define PK_FMA(acc, a, b) (acc) = __builtin_elementwise_fma((a), (b), (acc))
#define PK_FMA_BL(acc, a, b) (acc) = __builtin_elementwise_fma((f32x2){(a).x, (a).x}, (b), (acc))
#define PK_FMA_BH(acc, a, b) (acc) = __builtin_elementwise_fma((f32x2){(a).y, (a).y}, (b), (acc))
#define PK_BSUB(d, a, b) (d) = (f32x2){(a).x, (a).x} - (b)
#define XY(v) ((f32x2){(v).x, (v).y})
#define ZW(v) ((f32x2){(v).z, (v).w})
constexpr int SCAN_LDS_PER_WAVE = 4096;
__device__ __forceinline__ void unpack8(const v4u r, float (&f)[8]) {
#pragma unroll
    for (int i = 0; i < 4; ++i) { f[2 * i] = __builtin_bit_cast(float, r[i] << 16); f[2 * i + 1] = __builtin_bit_cast(float, r[i] & 0xffff0000u); }
}
__device__ __forceinline__ void scan_rwkv(Frame& F, const Args& A, int l, int b, int h, int seg) {
    int lane_ = lane_id(); asm volatile("" : "+v"(lane_));
    const int lane = lane_, ts = seg * LR;
    const bf16* recb = (const bf16*)(F.ws + WS_SC + SC_RWS) + (size_t)((b * 4 + h) * SEQ + ts) * 320;
    const v4u* rec = (const v4u*)recb + (lane < 40 ? lane : 39);
    LAS float* ring = (LAS float*)(F.lds + RING_OFF + F.wave * 16384);
    const bf16* vcol = ((bf16*)(F.ws + WS_PR)) + ((size_t)b * SEQ + ts) * PINP + SD0 + 512 + h * 64 + lane;
    bf16* ycol = ((bf16*)(F.ws + WS_PR)) + ((size_t)b * SEQ + ts) * PINP + SD0 + h * 64 + lane;
    const float mu_v = A.in[15][l * 896 + 512 + h * 64 + lane];
    const bool wl = (lane >= 8 && lane < 16);
    f32x2 S2[32], P2[32];
#pragma unroll
    for (int i = 0; i < 32; ++i) { S2[i] = (f32x2){0.f, 0.f}; P2[i] = (f32x2){(2 * i == lane) ? 1.f : 0.f, (2 * i + 1 == lane) ? 1.f : 0.f}; }
    float vprev = (ts > 0) ? bf2f(*(vcol - PINP)) : 0.f;
    constexpr int PD = 2;
    v4u rq[PD]; float vq[PD];
#pragma unroll
    for (int j = 0; j < PD; ++j) { rq[j] = rec[j * 40]; vq[j] = bf2f(vcol[(size_t)j * PINP]); }
    for (int t0 = 0; t0 < LR; t0 += PD) {
#pragma unroll
        for (int j = 0; j < PD; ++j) {
            const int t = t0 + j;
            LAS float* slot = ring + (j & 1) * 512;
            { float f[8]; unpack8(rq[j], f);
#pragma unroll
              for (int i = 0; i < 8; ++i) f[i] = wl ? 1.f - f[i] : f[i];
              if (lane < 40) { *(LAS f32x4*)(slot + 8 * lane) = (f32x4){f[0], f[1], f[2], f[3]}; *(LAS f32x4*)(slot + 8 * lane + 4) = (f32x4){f[4], f[5], f[6], f[7]}; } }
            const float vr = vq[j];
            { const int tn = (t + PD < LR) ? t + PD : LR - 1; rq[j] = rec[(size_t)tn * 40]; vq[j] = bf2f(vcol[(size_t)tn * PINP]); }
            const float v = vr + mu_v * (vprev - vr); vprev = vr;
            f32x2 sA0 = {0.f, 0.f}, sA1 = {0.f, 0.f}, pA0 = {0.f, 0.f}, pA1 = {0.f, 0.f};
#pragma unroll
            for (int g = 0; g < 16; ++g) { const f32x4 a = *(const LAS f32x4*)(slot + 4 * g); const f32x2 alo = XY(a), ahi = ZW(a);
                PK_FMA(sA0, S2[2 * g], alo); PK_FMA(pA0, P2[2 * g], alo); PK_FMA(sA1, S2[2 * g + 1], ahi); PK_FMA(pA1, P2[2 * g + 1], ahi); }
            const f32x2 sp = {(sA0.x + sA0.y) + (sA1.x + sA1.y), (pA0.x + pA0.y) + (pA1.x + pA1.y)};
            const f32x2 vv = {v, v};
            f32x2 yA0 = {0.f, 0.f}, yA1 = {0.f, 0.f}, zA0 = {0.f, 0.f}, zA1 = {0.f, 0.f};
#pragma unroll
            for (int g = 0; g < 16; ++g) {
                const f32x4 w = *(const LAS f32x4*)(slot + 64 + 4 * g), bb = *(const LAS f32x4*)(slot + 128 + 4 * g), kk = *(const LAS f32x4*)(slot + 192 + 4 * g), r = *(const LAS f32x4*)(slot + 256 + 4 * g);
                const f32x2 wl2 = XY(w), wh2 = ZW(w), bl2 = XY(bb), bh2 = ZW(bb), kl2 = XY(kk), kh2 = ZW(kk), rl2 = XY(r), rh2 = ZW(r);
                PK_MUL(S2[2 * g], S2[2 * g], wl2); PK_MUL(S2[2 * g + 1], S2[2 * g + 1], wh2); PK_MUL(P2[2 * g], P2[2 * g], wl2); PK_MUL(P2[2 * g + 1], P2[2 * g + 1], wh2);
                PK_FMA_BL(S2[2 * g], sp, bl2); PK_FMA_BL(S2[2 * g + 1], sp, bh2); PK_FMA_BH(P2[2 * g], sp, bl2); PK_FMA_BH(P2[2 * g + 1], sp, bh2);
                PK_FMA_BL(S2[2 * g], vv, kl2); PK_FMA_BL(S2[2 * g + 1], vv, kh2);
                PK_FMA(zA0, P2[2 * g], rl2); PK_FMA(zA1, P2[2 * g + 1], rh2); PK_FMA(yA0, S2[2 * g], rl2); PK_FMA(yA1, S2[2 * g + 1], rh2); }
            ycol[(size_t)t * PINP] = (bf16)f2bf((yA0.x + yA0.y) + (yA1.x + yA1.y));
            ycol[(size_t)t * PINP + 256] = (bf16)f2bf((zA0.x + zA0.y) + (zA1.x + zA1.y));
        }
    }
    int lane2 = lane; asm volatile("" : "+v"(lane2));
    const size_t item = (size_t)((b * 4 + h) * NSR + seg);
    float* so = (float*)((unsigned char*)F.out + CRW_S) + item * 4096 + lane2;
    bf16* po = (bf16*)((unsigned char*)F.out + CRW_P) + item * 4096 + lane2;
#pragma unroll
    for (int k = 0; k < 64; ++k) { so[k * 64] = S2[k >> 1][k & 1]; po[k * 64] = (bf16)f2bf(P2[k >> 1][k & 1]); }
}
__device__ __forceinline__ void scan_hgrn(Frame& F, int b, int h, int seg) {
    int lane_ = lane_id(); asm volatile("" : "+v"(lane_));
    const int lane = lane_, ts = seg * LH;
    const bf16* recb = (const bf16*)(F.ws + WS_SC + SC_HS) + (size_t)((b * 4 + h) * SEQ + ts) * 128;
    const v4u* rec = (const v4u*)recb + (lane & 15);
    LAS float* ring = (LAS float*)(F.lds + RING_OFF + F.wave * 16384);
    const bf16* vcol = ((bf16*)(F.ws + WS_PR)) + ((size_t)b * SEQ + ts) * PINP + SC0 + 512 + h * 64 + lane;
    bf16* ycol = ((bf16*)(F.ws + WS_PR)) + ((size_t)b * SEQ + ts) * PINP + SC0 + h * 64 + lane;
    f32x2 S2[32];
#pragma unroll
    for (int i = 0; i < 32; ++i) S2[i] = (f32x2){0.f, 0.f};
    float gam = 1.f;
    constexpr int PD = 4;
    v4u rq[PD]; float vq[PD];
#pragma unroll
    for (int j = 0; j < PD; ++j) { rq[j] = rec[j * 16]; vq[j] = bf2f(vcol[(size_t)j * PINP]); }
    for (int t0 = 0; t0 < LH; t0 += PD) {
#pragma unroll
        for (int j = 0; j < PD; ++j) {
            const int t = t0 + j;
            LAS float* slot = ring + (j & 1) * 512;
            { float f[8]; unpack8(rq[j], f);
              if (lane < 16) { *(LAS f32x4*)(slot + 8 * lane) = (f32x4){f[0], f[1], f[2], f[3]}; *(LAS f32x4*)(slot + 8 * lane + 4) = (f32x4){f[4], f[5], f[6], f[7]}; } }
            const float v = vq[j];
            { const int tn = (t + PD < LH) ? t + PD : LH - 1; rq[j] = rec[(size_t)tn * 16]; vq[j] = bf2f(vcol[(size_t)tn * PINP]); }
            const f32x2 vv = {v, v}; f32x2 yA0 = {0.f, 0.f}, yA1 = {0.f, 0.f};
#pragma unroll
            for (int g = 0; g < 16; ++g) { const f32x4 q = *(const LAS f32x4*)(slot + 4 * g), kk = *(const LAS f32x4*)(slot + 64 + 4 * g);
                f32x2 d0, d1; PK_BSUB(d0, vv, S2[2 * g]); PK_BSUB(d1, vv, S2[2 * g + 1]);
                PK_FMA(S2[2 * g], XY(kk), d0); PK_FMA(S2[2 * g + 1], ZW(kk), d1);
                PK_FMA(yA0, XY(q), S2[2 * g]); PK_FMA(yA1, ZW(q), S2[2 * g + 1]); }
            const float ql = slot[lane], kl = slot[64 + lane];
            gam *= (1.f - kl);
            ycol[(size_t)t * PINP] = (bf16)f2bf((yA0.x + yA0.y) + (yA1.x + yA1.y));
            ycol[(size_t)t * PINP + 256] = (bf16)f2bf(ql * gam);
        }
    }
    int lane2 = lane; asm volatile("" : "+v"(lane2));
    const size_t item = (size_t)((b * 4 + h) * NSH + seg);
    float* so = (float*)((unsigned char*)F.out + CH_S) + item * 4096 + lane2;
#pragma unroll
    for (int k = 0; k < 64; ++k) so[k * 64] = S2[k >> 1][k & 1];
    ((float*)((unsigned char*)F.out + CH_G))[item * 64 + lane2] = gam;
}
__device__ __forceinline__ void scan_gla(Frame& F, int b, int h, int seg) {
    int lane_ = lane_id(); asm volatile("" : "+v"(lane_));
    const int lane = lane_, ts = seg * LG, kl = lane & 31;
    const bf16* recb = (const bf16*)(F.ws + WS_SC + SC_GS) + (size_t)((b * 4 + h) * SEQ + ts) * 128;
    const v4u* rec = (const v4u*)recb + (lane & 15);
    LAS float* ring = (LAS float*)(F.lds + RING_OFF + F.wave * 16384);
    const bf16* vcol = ((bf16*)(F.ws + WS_PR)) + ((size_t)b * SEQ + ts) * PINP + SB0 + 256 + h * 64 + lane;
    bf16* ycol = ((bf16*)(F.ws + WS_PR)) + ((size_t)b * SEQ + ts) * PINP + SB0 + h * 64 + lane;
    bf16* zcol = ((bf16*)(F.ws + WS_ZG)) + ((size_t)b * SEQ + ts) * 128 + h * 32 + kl;
    const bool al = (lane >= 8 && lane < 12);
    f32x2 S2[16];
#pragma unroll
    for (int i = 0; i < 16; ++i) S2[i] = (f32x2){0.f, 0.f};
    float gam = 1.f;
    constexpr int PD = 8;
    v4u rq[PD]; float vq[PD];
#pragma unroll
    for (int j = 0; j < PD; ++j) { rq[j] = rec[j * 16]; vq[j] = bf2f(vcol[(size_t)j * PINP]); }
    for (int t0 = 0; t0 < LG; t0 += PD) {
#pragma unroll
        for (int j = 0; j < PD; ++j) {
            const int t = t0 + j;
            LAS float* slot = ring + (j & 1) * 512;
            { float f[8]; unpack8(rq[j], f);
#pragma unroll
              for (int i = 0; i < 8; ++i) f[i] = al ? 1.f - f[i] : f[i];
              if (lane < 12) { *(LAS f32x4*)(slot + 8 * lane) = (f32x4){f[0], f[1], f[2], f[3]}; *(LAS f32x4*)(slot + 8 * lane + 4) = (f32x4){f[4], f[5], f[6], f[7]}; } }
            const float v = vq[j];
            { const int tn = (t + PD < LG) ? t + PD : LG - 1; rq[j] = rec[(size_t)tn * 16]; vq[j] = bf2f(vcol[(size_t)tn * PINP]); }
            const f32x2 vv = {v, v}; f32x2 yA0 = {0.f, 0.f}, yA1 = {0.f, 0.f};
#pragma unroll
            for (int g = 0; g < 8; ++g) { const f32x4 q = *(const LAS f32x4*)(slot + 4 * g), kk = *(const LAS f32x4*)(slot + 32 + 4 * g), a = *(const LAS f32x4*)(slot + 64 + 4 * g);
                PK_MUL(S2[2 * g], S2[2 * g], XY(a)); PK_MUL(S2[2 * g + 1], S2[2 * g + 1], ZW(a));
                PK_FMA_BL(S2[2 * g], vv, XY(kk)); PK_FMA_BL(S2[2 * g + 1], vv, ZW(kk));
                PK_FMA(yA0, XY(q), S2[2 * g]); PK_FMA(yA1, ZW(q), S2[2 * g + 1]); }
            const float ql = slot[kl], av = slot[64 + kl];
            gam *= av;
            ycol[(size_t)t * PINP] = (bf16)f2bf((yA0.x + yA0.y) + (yA1.x + yA1.y));
            if (lane < 32) zcol[(size_t)t * 128] = (bf16)f2bf(ql * gam);
        }
    }
    int lane2 = lane; asm volatile("" : "+v"(lane2));
    const size_t item = (size_t)((b * 4 + h) * NSG + seg);
    float* so = (float*)((unsigned char*)F.out + CG_S) + item * 2048 + lane2;
#pragma unroll
    for (int k = 0; k < 32; ++k) so[k * 64] = S2[k >> 1][k & 1];
    if (lane2 < 32) ((float*)((unsigned char*)F.out + CG_G))[item * 32 + lane2] = gam;
}
template <int CTRL, int RM> __device__ __forceinline__ float dppz(float v) { return __builtin_bit_cast(float, __builtin_amdgcn_update_dpp(0, __builtin_bit_cast(int, v), CTRL, RM, 0xf, true)); }
__device__ __forceinline__ float scan32(float v) {
    v += dppz<0x111, 0xf>(v); v += dppz<0x112, 0xf>(v); v += dppz<0x114, 0xf>(v); v += dppz<0x118, 0xf>(v);
    v += dppz<0x142, 0xa>(v);
    return v;
}
template <int KD, bool GLA> __device__ __forceinline__ void chunk_scan(Frame& F, int b, int h, int seg) {
    constexpr int NC = KD / 16, NKT = KD / 32, L = GLA ? LG : LH, NS = GLA ? NSG : NSH, KOFF = GLA ? 32 : 64, DOFF = 64;
    int lane_ = lane_id(); asm volatile("" : "+v"(lane_));
    const int lane = lane_, r32 = lane & 31, hi = lane >> 5, ts = seg * L;
    const bf16* recb = (const bf16*)(F.ws + WS_SC + (GLA ? SC_GS : SC_HS)) + (size_t)((b * 4 + h) * SEQ + ts) * 128;
    const size_t mrow = (size_t)b * SEQ + ts;
    const bf16* vbase = ((bf16*)(F.ws + WS_PR)) + mrow * PINP + (GLA ? SB0 + 256 : SC0 + 512) + h * 64;
    bf16* ybase = ((bf16*)(F.ws + WS_PR)) + mrow * PINP + (GLA ? SB0 : SC0) + h * 64;
    bf16* zbase = GLA ? ((bf16*)(F.ws + WS_ZG)) + mrow * 128 + h * 32 : ((bf16*)(F.ws + WS_PR)) + mrow * PINP + SC0 + 256 + h * 64;
    constexpr int ZP = GLA ? 128 : PINP;
    LAS unsigned char* vimg = F.lds + RING_OFF + F.wave * 16384;
    LAS unsigned char* kimg = vimg + 8192;
    const att::lds_cptr vrd = (att::lds_cptr)vimg + ((lane >> 4) & 1) * 32 + (lane & 3) * 8 + (4 * hi + ((lane & 15) >> 2)) * 64;
    const att::lds_cptr krd = vrd + 8192;
    f32x16 S[NKT][2];
#pragma unroll
    for (int kt = 0; kt < NKT; ++kt) { S[kt][0] = f32x16{}; S[kt][1] = f32x16{}; }
    LAS float* Bprev = (LAS float*)(F.lds + MISC_OFF + 1024 + F.wave * 512) + hi * 32;
    LAS float* Bend = Bprev + 64;
    if (r32 == 0) {
#pragma unroll
        for (int i = 0; i < NC * 8; ++i) Bprev[i] = 0.f; }
    for (int ch = 0; ch < L / 64; ++ch) {
        const int tc = ch * 64;
        int lc_ = lane; asm volatile("" : "+v"(lc_)); const int r32 = lc_ & 31, hi = lc_ >> 5;
        u32x2 rq[2][6];
#define CS_LOAD(bf_, c_, T_) do { const int k0_ = 32 * ((c_) >> 1) + 16 * ((c_) & 1) + 4 * hi; const bf16* rp_ = recb + (size_t)(tc + 32 * (T_) + r32) * 128; \
            rq[bf_][0] = *(const u32x2*)(rp_ + k0_); rq[bf_][1] = *(const u32x2*)(rp_ + k0_ + 8); rq[bf_][2] = *(const u32x2*)(rp_ + KOFF + k0_); rq[bf_][3] = *(const u32x2*)(rp_ + KOFF + k0_ + 8); \
            rq[bf_][4] = *(const u32x2*)(rp_ + DOFF + k0_); rq[bf_][5] = *(const u32x2*)(rp_ + DOFF + k0_ + 8); } while (0)
        { const int cn = lane & 7, s0 = lane >> 3; const bf16* vp = vbase + (size_t)(tc + s0) * PINP + cn * 8; LAS unsigned char* vw = vimg + (cn >> 2) * 4096 + s0 * 64 + (cn & 3) * 16;
          v4u x[8];
#pragma unroll
          for (int i = 0; i < 8; ++i) { x[i] = *(const v4u*)vp; vp += 8 * PINP; }
          CS_LOAD(0, 0, 0);
          __builtin_amdgcn_sched_barrier(0);
#pragma unroll
          for (int i = 0; i < 8; ++i) *(LAS v4u*)(vw + i * 512) = x[i]; }
        bf16x8 Qh[2][NC];
#pragma unroll
        for (int c = 0; c < NC; ++c) {
            const int k0 = 32 * (c >> 1) + 16 * (c & 1) + 4 * hi;
            float carry[8];
#pragma unroll
            for (int j = 0; j < 8; ++j) carry[j] = 0.f;
#pragma unroll
            for (int T = 0; T < 2; ++T) {
                constexpr int dummy0_ = 0; (void)dummy0_;
                const int idx = 2 * c + T;
                if (idx + 1 < 2 * NC) { if (T == 0) CS_LOAD((idx + 1) & 1, c, 1); else CS_LOAD((idx + 1) & 1, c + 1, 0); }
                __builtin_amdgcn_sched_barrier(0);
                const u32x2 qa = rq[idx & 1][0], qb = rq[idx & 1][1], ka = rq[idx & 1][2], kb = rq[idx & 1][3], da = rq[idx & 1][4], db = rq[idx & 1][5];
                float q[8], kk[8], d[8];
#define UNP(dst, a2, b2) dst[0] = __builtin_bit_cast(float, a2.x << 16); dst[1] = __builtin_bit_cast(float, a2.x & 0xffff0000u); dst[2] = __builtin_bit_cast(float, a2.y << 16); dst[3] = __builtin_bit_cast(float, a2.y & 0xffff0000u); \
                dst[4] = __builtin_bit_cast(float, b2.x << 16); dst[5] = __builtin_bit_cast(float, b2.x & 0xffff0000u); dst[6] = __builtin_bit_cast(float, b2.y << 16); dst[7] = __builtin_bit_cast(float, b2.y & 0xffff0000u);
                UNP(q, qa, qb) UNP(kk, ka, kb) UNP(d, da, db)
#undef UNP
                float qh[8], kh[8], zz[8];
#pragma unroll
                for (int j = 0; j < 8; ++j) {
                    const float g = __logf(1.f - d[j]);
                    const float Bv = scan32(g) + carry[j];
                    const float tot = __shfl(Bv, (lane & 32) | 31);
                    if (T == 0) carry[j] = tot; else if (r32 == 0) Bend[c * 8 + j] = tot;
                    qh[j] = q[j] * __expf(Bv); kh[j] = kk[j] * __expf(fminf(-Bv, 80.f)); zz[j] = q[j] * __expf(Bv + Bprev[c * 8 + j]);
                }
                u32x4 qp; qp.x = pk2(qh[0], qh[1]); qp.y = pk2(qh[2], qh[3]); qp.z = pk2(qh[4], qh[5]); qp.w = pk2(qh[6], qh[7]);
                Qh[T][c] = __builtin_bit_cast(bf16x8, qp);
                const int s = 32 * T + r32;
                LAS unsigned char* kw = kimg + (c >> 1) * 4096 + s * 64 + (k0 & 31) * 2;
                *(LAS u32x2*)kw = (u32x2){pk2(kh[0], kh[1]), pk2(kh[2], kh[3])}; *(LAS u32x2*)(kw + 16) = (u32x2){pk2(kh[4], kh[5]), pk2(kh[6], kh[7])};
                bf16* zw = zbase + (size_t)(tc + s) * ZP + k0;
                *(u32x2*)zw = (u32x2){pk2(zz[0], zz[1]), pk2(zz[2], zz[3])}; *(u32x2*)(zw + 8) = (u32x2){pk2(zz[4], zz[5]), pk2(zz[6], zz[7])};
            }
        }
#undef CS_LOAD
#pragma unroll
        for (int tT = 0; tT < 2; ++tT) {
            f32x16 O[2]; O[0] = f32x16{}; O[1] = f32x16{};
#pragma unroll
            for (int c = 0; c < NC; ++c)
#pragma unroll
                for (int vt = 0; vt < 2; ++vt) { const f32x16& St = S[c >> 1][vt]; const int o = 8 * (c & 1);
                    u32x4 sp; sp.x = pk2(St[o], St[o + 1]); sp.y = pk2(St[o + 2], St[o + 3]); sp.z = pk2(St[o + 4], St[o + 5]); sp.w = pk2(St[o + 6], St[o + 7]);
                    O[vt] = __builtin_amdgcn_mfma_f32_32x32x16_bf16(Qh[tT][c], __builtin_bit_cast(bf16x8, sp), O[vt], 0, 0, 0); }
#pragma unroll
            for (int sT = 0; sT <= tT; ++sT) {
                f32x16 ST = f32x16{};
#pragma unroll
                for (int c = 0; c < NC; ++c) { const int k0 = 32 * (c >> 1) + 16 * (c & 1) + 4 * hi;
                    const LAS unsigned char* kr = kimg + (c >> 1) * 4096 + (32 * sT + r32) * 64 + (k0 & 31) * 2;
                    const u32x2 a0 = *(const LAS u32x2*)kr, a1 = *(const LAS u32x2*)(kr + 16);
                    const u32x4 a4 = {a0.x, a0.y, a1.x, a1.y};
                    ST = __builtin_amdgcn_mfma_f32_32x32x16_bf16(__builtin_bit_cast(bf16x8, a4), Qh[tT][c], ST, 0, 0, 0); }
                if (sT == tT) { int dl = r32 - 4 * hi; asm volatile("" : "+v"(dl));
#pragma unroll
                    for (int r = 0; r < 16; ++r) if ((r & 3) + 8 * (r >> 2) > dl) ST[r] = 0.f;
                }
#pragma unroll
                for (int half = 0; half < 2; ++half) { const int o = 8 * half;
                    u32x4 pw; pw.x = pk2(ST[o], ST[o + 1]); pw.y = pk2(ST[o + 2], ST[o + 3]); pw.z = pk2(ST[o + 4], ST[o + 5]); pw.w = pk2(ST[o + 6], ST[o + 7]);
#pragma unroll
                    for (int vt = 0; vt < 2; ++vt) { const int blk = 2 * sT + half;
                        const s16x4 vlo = att::vtr(vrd + vt * 4096 + blk * 1024), vhi = att::vtr(vrd + vt * 4096 + blk * 1024 + 512);
                        const bf16x8 vf = (bf16x8){vlo[0], vlo[1], vlo[2], vlo[3], vhi[0], vhi[1], vhi[2], vhi[3]};
                        O[vt] = __builtin_amdgcn_mfma_f32_32x32x16_bf16(__builtin_bit_cast(bf16x8, pw), vf, O[vt], 0, 0, 0); } }
            }
            { bf16* yp = ybase + (size_t)(tc + 32 * tT + 4 * hi) * PINP + r32;
#pragma unroll
              for (int r = 0; r < 16; ++r) { yp[0] = (bf16)f2bf(O[0][r]); yp[32] = (bf16)f2bf(O[1][r]); yp += ((r & 3) == 3 ? 5 : 1) * PINP; } }
        }
#pragma unroll
        for (int kt = 0; kt < NKT; ++kt)
#pragma unroll
            for (int vt = 0; vt < 2; ++vt) { f32x16 acc = S[kt][vt];
#pragma unroll
                for (int blk = 0; blk < 4; ++blk) {
                    const s16x4 klo = att::vtr(krd + kt * 4096 + blk * 1024), khi = att::vtr(krd + kt * 4096 + blk * 1024 + 512);
                    const s16x4 vlo = att::vtr(vrd + vt * 4096 + blk * 1024), vhi = att::vtr(vrd + vt * 4096 + blk * 1024 + 512);
                    const bf16x8 kf = (bf16x8){klo[0], klo[1], klo[2], klo[3], khi[0], khi[1], khi[2], khi[3]}, vf = (bf16x8){vlo[0], vlo[1], vlo[2], vlo[3], vhi[0], vhi[1], vhi[2], vhi[3]};
                    acc = __builtin_amdgcn_mfma_f32_32x32x16_bf16(kf, vf, acc, 0, 0, 0); }
#pragma unroll
                for (int r = 0; r < 16; ++r) acc[r] *= __expf(Bend[(2 * kt + (r >> 3)) * 8 + (r & 7)]);
                S[kt][vt] = acc; }
        if (r32 == 0) {
#pragma unroll
            for (int i = 0; i < NC * 8; ++i) Bprev[i] += Bend[i]; }
    }
    int lane2 = lane; asm volatile("" : "+v"(lane2));
    const int r32b = lane2 & 31, hib = lane2 >> 5;
    const size_t item = (size_t)((b * 4 + h) * NS + seg);
    float* so = (float*)((unsigned char*)F.out + (GLA ? CG_S : CH_S)) + item * (KD * 64);
#pragma unroll
    for (int kt = 0; kt < NKT; ++kt)
#pragma unroll
        for (int vt = 0; vt < 2; ++vt)
#pragma unroll
            for (int r = 0; r < 16; ++r) so[(32 * kt + crow32(r, hib)) * 64 + 32 * vt + r32b] = S[kt][vt][r];
    if (r32b == 0) { float* go = (float*)((unsigned char*)F.out + (GLA ? CG_G : CH_G)) + item * KD;
#pragma unroll
        for (int c = 0; c < NC; ++c)
#pragma unroll
            for (int j = 0; j < 8; ++j) go[32 * (c >> 1) + crow32(j + 8 * (c & 1), hib)] = __expf(Bprev[c * 8 + j]); }
}
template <bool WA, bool WR, bool WB, bool WK>
__device__ __forceinline__ void rw_ops(const bf16* recb, int r32, int hi, int lane, bf16x8 (&At)[2][4], bf16x8 (&Rt)[2][4], bf16x8 (&Bb)[2][4], bf16x8 (&Kb)[2][4], LAS float* bend, bool wbend) {
#define RW_UNP(dst, a2, b2) dst[0] = __builtin_bit_cast(float, a2.x << 16); dst[1] = __builtin_bit_cast(float, a2.x & 0xffff0000u); dst[2] = __builtin_bit_cast(float, a2.y << 16); dst[3] = __builtin_bit_cast(float, a2.y & 0xffff0000u); \
    dst[4] = __builtin_bit_cast(float, b2.x << 16); dst[5] = __builtin_bit_cast(float, b2.x & 0xffff0000u); dst[6] = __builtin_bit_cast(float, b2.y << 16); dst[7] = __builtin_bit_cast(float, b2.y & 0xffff0000u);
#define RW_PK(dst, f) { u32x4 p_; p_.x = pk2(f[0], f[1]); p_.y = pk2(f[2], f[3]); p_.z = pk2(f[4], f[5]); p_.w = pk2(f[6], f[7]); dst = __builtin_bit_cast(bf16x8, p_); }
#pragma unroll
    for (int cp = 0; cp < 2; ++cp) {
        u32x2 rd[2][2][2], ra[2][2][2], rr[2][2][2], rb[2][2][2], rk[2][2][2];
#pragma unroll
        for (int ci = 0; ci < 2; ++ci)
#pragma unroll
            for (int T = 0; T < 2; ++T) { const int c = 2 * cp + ci, k0 = 32 * (c >> 1) + 16 * (c & 1) + 4 * hi;
                const bf16* rp = recb + (size_t)(32 * T + r32) * 320 + k0;
                rd[ci][T][0] = *(const u32x2*)(rp + 64); rd[ci][T][1] = *(const u32x2*)(rp + 72);
                if (WA) { ra[ci][T][0] = *(const u32x2*)(rp); ra[ci][T][1] = *(const u32x2*)(rp + 8); }
                if (WR) { rr[ci][T][0] = *(const u32x2*)(rp + 256); rr[ci][T][1] = *(const u32x2*)(rp + 264); }
                if (WB) { rb[ci][T][0] = *(const u32x2*)(rp + 128); rb[ci][T][1] = *(const u32x2*)(rp + 136); }
                if (WK) { rk[ci][T][0] = *(const u32x2*)(rp + 192); rk[ci][T][1] = *(const u32x2*)(rp + 200); } }
#pragma unroll
        for (int ci = 0; ci < 2; ++ci) { const int c = 2 * cp + ci;
            float carry[8];
#pragma unroll
            for (int j = 0; j < 8; ++j) carry[j] = 0.f;
#pragma unroll
            for (int T = 0; T < 2; ++T) {
                float d[8]; RW_UNP(d, rd[ci][T][0], rd[ci][T][1])
                float ei[8], ex[8], ev[8];
#pragma unroll
                for (int j = 0; j < 8; ++j) {
                    const float g = __logf(1.f - d[j]);
                    const float Bv = scan32(g) + carry[j];
                    const float tot = __shfl(Bv, (lane & 32) | 31);
                    if (T == 0) carry[j] = tot; else if (wbend && r32 == 0) bend[c * 8 + j] = tot;
                    ei[j] = __expf(Bv); ex[j] = __expf(Bv - g); ev[j] = __expf(fminf(-Bv, 80.f));
                }
                if (WA) { float f[8]; RW_UNP(f, ra[ci][T][0], ra[ci][T][1])
#pragma unroll
                    for (int j = 0; j < 8; ++j) f[j] *= ex[j];
                    RW_PK(At[T][c], f) }
                if (WR) { float f[8]; RW_UNP(f, rr[ci][T][0], rr[ci][T][1])
#pragma unroll
                    for (int j = 0; j < 8; ++j) f[j] *= ei[j];
                    RW_PK(Rt[T][c], f) }
                if (WB) { float f[8]; RW_UNP(f, rb[ci][T][0], rb[ci][T][1])
#pragma unroll
                    for (int j = 0; j < 8; ++j) f[j] *= ev[j];
                    RW_PK(Bb[T][c], f) }
                if (WK) { float f[8]; RW_UNP(f, rk[ci][T][0], rk[ci][T][1])
#pragma unroll
                    for (int j = 0; j < 8; ++j) f[j] *= ev[j];
                    RW_PK(Kb[T][c], f) }
            }
        }
        __builtin_amdgcn_sched_barrier(0);
    }
#undef RW_UNP
#undef RW_PK
}
__device__ __forceinline__ void rw_image(LAS unsigned char* img, const bf16x8 (&X)[2][4], int r32, int hi) {
#pragma unroll
    for (int T = 0; T < 2; ++T)
#pragma unroll
        for (int c = 0; c < 4; ++c) { const int k0 = 32 * (c >> 1) + 16 * (c & 1) + 4 * hi; const u32x4 v = __builtin_bit_cast(u32x4, X[T][c]);
            LAS unsigned char* w = img + (c >> 1) * 4096 + (32 * T + r32) * 64 + (k0 & 31) * 2;
            *(LAS u32x2*)w = (u32x2){v.x, v.y}; *(LAS u32x2*)(w + 16) = (u32x2){v.z, v.w}; }
}
#define RW_PACKH(dst, acc, o) { u32x4 p_; p_.x = pk2(acc[o], acc[o + 1]); p_.y = pk2(acc[o + 2], acc[o + 3]); p_.z = pk2(acc[o + 4], acc[o + 5]); p_.w = pk2(acc[o + 6], acc[o + 7]); dst = __builtin_bit_cast(bf16x8, p_); }
#define RW_VTR(base, dh, blk) ({ const s16x4 lo_ = att::vtr((base) + (dh) * 4096 + (blk) * 1024), hi_ = att::vtr((base) + (dh) * 4096 + (blk) * 1024 + 512); (bf16x8){lo_[0], lo_[1], lo_[2], lo_[3], hi_[0], hi_[1], hi_[2], hi_[3]}; })
#ifndef RWC_STAGE
#define RWC_STAGE 4
#endif
__device__ __forceinline__ void rwkv_chunk(Frame& F, const Args& A, int l, int b, int h, int seg) {
    int lane_ = lane_id(); asm volatile("" : "+v"(lane_));
    const int lane = lane_, ts = seg * 64; int r32 = lane & 31, hi = lane >> 5;
    const bf16* recb = (const bf16*)(F.ws + WS_SC + SC_RWS) + (size_t)((b * 4 + h) * SEQ + ts) * 320;
    const size_t mrow = (size_t)b * SEQ + ts;
    bf16* PRr = (bf16*)(F.ws + WS_PR) + mrow * PINP + SD0 + h * 64;
    LAS unsigned char* buf0 = F.lds + RING_OFF + F.wave * 16384;
    LAS unsigned char* buf1 = buf0 + 8192;
    LAS float* Al = (LAS float*)buf0;
    LAS float* bend = (LAS float*)(F.lds + MISC_OFF + 1024 + F.wave * 512) + hi * 32 + 64;
    att::lds_cptr rd0 = (att::lds_cptr)buf0 + ((lane >> 4) & 1) * 32 + (lane & 3) * 8 + (4 * hi + ((lane & 15) >> 2)) * 64;
    att::lds_cptr rd1 = rd0 + 8192;
#define RW_FENCE() do { __builtin_amdgcn_sched_barrier(0); int lq_ = lane; asm volatile("" : "+v"(lq_)); r32 = lq_ & 31; hi = lq_ >> 5; \
        bend = (LAS float*)(F.lds + MISC_OFF + 1024 + F.wave * 512) + hi * 32 + 64; \
        rd0 = (att::lds_cptr)buf0 + ((lq_ >> 4) & 1) * 32 + (lq_ & 3) * 8 + (4 * hi + ((lq_ & 15) >> 2)) * 64; rd1 = rd0 + 8192; } while (0)
    bf16x8 At[2][4], Rt[2][4], Bb[2][4], Kb[2][4];
    { int z_ = 0; asm volatile("" : "+s"(z_)); rw_ops<true, false, true, true>(recb + z_, r32, hi, lane, At, Rt, Bb, Kb, bend, true); }
    RW_FENCE();
#pragma unroll
    for (int tT = 0; tT < 2; ++tT)
#pragma unroll
        for (int sT = 0; sT < 2; ++sT) {
            f32x16 acc = f32x16{};
            if (sT <= tT) {
#pragma unroll
                for (int c = 0; c < 4; ++c) acc = __builtin_amdgcn_mfma_f32_32x32x16_bf16(At[tT][c], Bb[sT][c], acc, 0, 0, 0);
            }
#pragma unroll
            for (int r = 0; r < 16; ++r) { const int t = 32 * tT + crow32(r, hi), s = 32 * sT + r32; Al[t * 64 + s] = (s < t) ? acc[r] : 0.f; }
        }
    RW_FENCE();
    bf16x8 akp[3][2];
#pragma unroll
    for (int ti = 0; ti < 3; ++ti) { const int sT = ti >> 1, tT = (ti + 1) >> 1;
        f32x16 acc = f32x16{};
#pragma unroll
        for (int c = 0; c < 4; ++c) acc = __builtin_amdgcn_mfma_f32_32x32x16_bf16(Kb[sT][c], At[tT][c], acc, 0, 0, 0);
#pragma unroll
        for (int r = 0; r < 16; ++r) if (32 * sT + crow32(r, hi) >= 32 * tT + r32) acc[r] = 0.f;
        RW_PACKH(akp[ti][0], acc, 0) RW_PACKH(akp[ti][1], acc, 8) }
    v4u vcur[8];
    { const bf16* vp = PRr + 512 + (size_t)(lane >> 3) * PINP + (lane & 7) * 8;
#pragma unroll
      for (int i = 0; i < 8; ++i) { vcur[i] = *(const v4u*)vp; vp += 8 * PINP; } }
    RW_FENCE();
    float x[64];
#pragma unroll
    for (int s = 0; s < 64; ++s) x[s] = (s == lane) ? 1.f : 0.f;
#pragma unroll
    for (int sp = 63; sp >= 1; --sp) {
#pragma unroll
        for (int g4 = 0; g4 * 4 < sp; ++g4) { const f32x4 a4 = *(const LAS f32x4*)(Al + sp * 64 + 4 * g4);
#define FMAC1(acc, a, b) asm("v_fmac_f32 %0, %1, %2" : "+v"(acc) : "v"(a), "v"(b))
            FMAC1(x[4 * g4], x[sp], a4.x); if (4 * g4 + 1 < sp) FMAC1(x[4 * g4 + 1], x[sp], a4.y); if (4 * g4 + 2 < sp) FMAC1(x[4 * g4 + 2], x[sp], a4.z); if (4 * g4 + 3 < sp) FMAC1(x[4 * g4 + 3], x[sp], a4.w); }
        if ((sp & 3) == 0) __builtin_amdgcn_sched_barrier(0);
    }
    RW_FENCE();
    float TT[3][16];
#pragma unroll
    for (int sT = 0; sT < 2; ++sT)
#pragma unroll
        for (int r = 0; r < 16; ++r) { const int rho = 32 * sT + (r & 3) + 8 * (r >> 2);
            auto sw = __builtin_amdgcn_permlane32_swap(__float_as_uint(x[rho]), __float_as_uint(x[rho + 4]), false, false);
            if (sT == 0) { TT[0][r] = __uint_as_float(sw[0]); TT[1][r] = __uint_as_float(sw[1]); } else TT[2][r] = __uint_as_float(sw[1]); }
    bf16x8 Wpk[2][2][2], Tpk[3][2];
    RW_FENCE();
    rw_image(buf1, At, r32, hi);
#pragma unroll
    for (int ti = 0; ti < 3; ++ti) { RW_PACKH(Tpk[ti][0], TT[ti], 0) RW_PACKH(Tpk[ti][1], TT[ti], 8) }
#pragma unroll
    for (int tT = 0; tT < 2; ++tT)
#pragma unroll
        for (int kt = 0; kt < 2; ++kt) { f32x16 acc = f32x16{};
#pragma unroll
            for (int sT = 0; sT <= tT; ++sT) { const int ti = (tT == 0) ? 0 : 1 + sT;
#pragma unroll
                for (int hf = 0; hf < 2; ++hf) acc = __builtin_amdgcn_mfma_f32_32x32x16_bf16(Tpk[ti][hf], RW_VTR(rd1, kt, 2 * sT + hf), acc, 0, 0, 0); }
            RW_PACKH(Wpk[tT][kt][0], acc, 0) RW_PACKH(Wpk[tT][kt][1], acc, 8) }
#define RW_PARK(slot) ((u32x4*)((unsigned char*)F.out + 192 * MiB) + (size_t)(F.wave * F.G + (int)blockIdx.x) * 1536 + (slot) * 512 + (r32 + 32 * hi))
    u32x4* wpark = RW_PARK(0);
#pragma unroll
    for (int tT = 0; tT < 2; ++tT)
#pragma unroll
        for (int kt = 0; kt < 2; ++kt)
#pragma unroll
            for (int hf = 0; hf < 2; ++hf) wpark[((tT * 2 + kt) * 2 + hf) * 64] = __builtin_bit_cast(u32x4, Wpk[tT][kt][hf]);
    RW_FENCE();
    { const int cn = lane & 7, s0 = lane >> 3; const bf16* vp = PRr + 512 + (size_t)s0 * PINP + cn * 8; LAS unsigned char* vw = buf0 + (cn >> 2) * 4096 + s0 * 64 + (cn & 3) * 16;
      float mu8[8];
#pragma unroll
      for (int e = 0; e < 8; ++e) mu8[e] = A.in[15][l * 896 + 512 + h * 64 + cn * 8 + e];
      v4u vprv[8];
#pragma unroll
      for (int i = 0; i < 8; ++i) { const bool has = (ts + s0 + 8 * i) > 0; vprv[i] = *(const v4u*)(vp - (has ? PINP : 0)); vp += 8 * PINP; }
#pragma unroll
      for (int i = 0; i < 8; ++i) { const bool has = (ts + s0 + 8 * i) > 0;
          float fc[8], fp[8]; unpack8(vcur[i], fc); unpack8(vprv[i], fp);
          v4u o;
#pragma unroll
          for (int e = 0; e < 4; ++e) { const float p0 = has ? fp[2 * e] : 0.f, p1 = has ? fp[2 * e + 1] : 0.f; o[e] = pk2(fc[2 * e] + mu8[2 * e] * (p0 - fc[2 * e]), fc[2 * e + 1] + mu8[2 * e + 1] * (p1 - fc[2 * e + 1])); }
          *(LAS v4u*)(vw + i * 512) = o; } }
    RW_FENCE();
    bf16x8 Upk[2][2][2];
#pragma unroll
    for (int vt = 0; vt < 2; ++vt) {
        f32x16 X[2];
#pragma unroll
        for (int tT = 0; tT < 2; ++tT) { f32x16 acc = f32x16{};
#pragma unroll
            for (int sT = 0; sT <= tT; ++sT) { const int ti = sT + tT;
#pragma unroll
                for (int hf = 0; hf < 2; ++hf) acc = __builtin_amdgcn_mfma_f32_32x32x16_bf16(akp[ti][hf], RW_VTR(rd0, vt, 2 * sT + hf), acc, 0, 0, 0); }
            X[tT] = acc; }
#pragma unroll
        for (int tT = 0; tT < 2; ++tT) { f32x16 acc = f32x16{};
#pragma unroll
            for (int sT = 0; sT <= tT; ++sT) { const int ti = (tT == 0) ? 0 : 1 + sT;
#pragma unroll
                for (int r = 0; r < 16; ++r) acc = __builtin_amdgcn_mfma_f32_32x32x2f32(TT[ti][r], X[sT][r], acc, 0, 0, 0); }
            RW_PACKH(Upk[tT][vt][0], acc, 0) RW_PACKH(Upk[tT][vt][1], acc, 8) }
        __builtin_amdgcn_sched_barrier(0);
    }
    { u32x4* up = RW_PARK(1);
#pragma unroll
      for (int tT = 0; tT < 2; ++tT)
#pragma unroll
          for (int vt = 0; vt < 2; ++vt)
#pragma unroll
              for (int hf = 0; hf < 2; ++hf) up[((tT * 2 + vt) * 2 + hf) * 64] = __builtin_bit_cast(u32x4, Upk[tT][vt][hf]); }
    RW_FENCE();
    { int z_ = 0; asm volatile("" : "+s"(z_)); rw_ops<false, true, true, true>(recb + z_, r32, hi, lane, At, Rt, Bb, Kb, bend, false); }
    RW_FENCE();
    bf16x8 arp[3][2], akr[3][2];
#pragma unroll
    for (int ti = 0; ti < 3; ++ti) { const int sT = ti >> 1, tT = (ti + 1) >> 1;
        f32x16 a1 = f32x16{}, a2 = f32x16{};
#pragma unroll
        for (int c = 0; c < 4; ++c) { a1 = __builtin_amdgcn_mfma_f32_32x32x16_bf16(Bb[sT][c], Rt[tT][c], a1, 0, 0, 0); a2 = __builtin_amdgcn_mfma_f32_32x32x16_bf16(Kb[sT][c], Rt[tT][c], a2, 0, 0, 0); }
#pragma unroll
        for (int r = 0; r < 16; ++r) if (32 * sT + crow32(r, hi) > 32 * tT + r32) { a1[r] = 0.f; a2[r] = 0.f; }
        RW_PACKH(arp[ti][0], a1, 0) RW_PACKH(arp[ti][1], a1, 8) RW_PACKH(akr[ti][0], a2, 0) RW_PACKH(akr[ti][1], a2, 8) }
    { u32x4* rp_ = RW_PARK(2);
#pragma unroll
      for (int T = 0; T < 2; ++T)
#pragma unroll
          for (int c = 0; c < 4; ++c) rp_[(T * 4 + c) * 64] = __builtin_bit_cast(u32x4, Rt[T][c]); }
    RW_FENCE();
    { int z_ = 0; asm volatile("" : "+s"(z_)); const u32x4* up = RW_PARK(1) + z_;
#pragma unroll
      for (int tT = 0; tT < 2; ++tT)
#pragma unroll
          for (int vt = 0; vt < 2; ++vt)
#pragma unroll
              for (int hf = 0; hf < 2; ++hf) Upk[tT][vt][hf] = __builtin_bit_cast(bf16x8, up[((tT * 2 + vt) * 2 + hf) * 64]); }
#pragma unroll
    for (int tT = 0; tT < 2; ++tT) { f32x16 Y[2]; Y[0] = f32x16{}; Y[1] = f32x16{};
#pragma unroll
        for (int sT = 0; sT <= tT; ++sT) { const int ti = sT + tT;
#pragma unroll
            for (int hf = 0; hf < 2; ++hf)
#pragma unroll
                for (int vt = 0; vt < 2; ++vt) { Y[vt] = __builtin_amdgcn_mfma_f32_32x32x16_bf16(arp[ti][hf], Upk[sT][vt][hf], Y[vt], 0, 0, 0);
                    Y[vt] = __builtin_amdgcn_mfma_f32_32x32x16_bf16(akr[ti][hf], RW_VTR(rd0, vt, 2 * sT + hf), Y[vt], 0, 0, 0); } }
        { const int yo = (32 * tT + 4 * hi) * PINP + r32;
#pragma unroll
          for (int r = 0; r < 16; ++r) { const int ro = yo + ((r & 3) + 8 * (r >> 2)) * PINP; PRr[ro] = (bf16)f2bf(Y[0][r]); PRr[ro + 32] = (bf16)f2bf(Y[1][r]); } } }
    const size_t item = (size_t)((b * 4 + h) * NSR + seg);
#if RWC_STAGE >= 2
    RW_FENCE();
    { f32x16 Sl[2][2];
      rw_image(buf1, Bb, r32, hi);
#pragma unroll
      for (int kt = 0; kt < 2; ++kt)
#pragma unroll
          for (int vt = 0; vt < 2; ++vt) { f32x16 acc = f32x16{};
#pragma unroll
              for (int blk = 0; blk < 4; ++blk) acc = __builtin_amdgcn_mfma_f32_32x32x16_bf16(RW_VTR(rd1, kt, blk), Upk[blk >> 1][vt][blk & 1], acc, 0, 0, 0);
              Sl[kt][vt] = acc; }
      rw_image(buf1, Kb, r32, hi);
#pragma unroll
      for (int kt = 0; kt < 2; ++kt)
#pragma unroll
          for (int vt = 0; vt < 2; ++vt) { f32x16 acc = Sl[kt][vt];
#pragma unroll
              for (int blk = 0; blk < 4; ++blk) acc = __builtin_amdgcn_mfma_f32_32x32x16_bf16(RW_VTR(rd1, kt, blk), RW_VTR(rd0, vt, blk), acc, 0, 0, 0);
              u32x4* so = (u32x4*)((unsigned char*)F.out + CRW_S) + item * 512 + ((kt * 2 + vt) * 64 + (r32 + 32 * hi)) * 2;
#pragma unroll
              for (int q = 0; q < 2; ++q) { u32x4 v4;
#pragma unroll
                  for (int e = 0; e < 4; ++e) { const int r = 8 * q + 2 * e;
                      v4[e] = pk2(acc[r] * __expf(bend[(2 * kt + (r >> 3)) * 8 + (r & 7)]), acc[r + 1] * __expf(bend[(2 * kt + ((r + 1) >> 3)) * 8 + ((r + 1) & 7)])); }
                  so[q] = v4; } } }
#endif
#if RWC_STAGE >= 3
    RW_FENCE();
    { int z_ = 0; asm volatile("" : "+s"(z_)); const u32x4* wp2 = RW_PARK(0) + z_;
#pragma unroll
      for (int tT = 0; tT < 2; ++tT)
#pragma unroll
          for (int kt = 0; kt < 2; ++kt)
#pragma unroll
              for (int hf = 0; hf < 2; ++hf) Wpk[tT][kt][hf] = __builtin_bit_cast(bf16x8, wp2[((tT * 2 + kt) * 2 + hf) * 64]); }
    { int z_ = 0; asm volatile("" : "+s"(z_)); const u32x4* rp_ = RW_PARK(2) + z_;
#pragma unroll
      for (int T = 0; T < 2; ++T)
#pragma unroll
          for (int c = 0; c < 4; ++c) Rt[T][c] = __builtin_bit_cast(bf16x8, rp_[(T * 4 + c) * 64]); }
    rw_image(buf1, Rt, r32, hi);
    bf16x8 Ipk[2];
    { float f0[8], f1[8];
#pragma unroll
      for (int j = 0; j < 8; ++j) { f0[j] = (crow32(j, hi) == r32) ? 1.f : 0.f; f1[j] = (crow32(j + 8, hi) == r32) ? 1.f : 0.f; }
      RW_PACKH(Ipk[0], f0, 0) RW_PACKH(Ipk[1], f1, 0) }
#pragma unroll
    for (int tT = 0; tT < 2; ++tT) { f32x16 Z[2]; Z[0] = f32x16{}; Z[1] = f32x16{};
#pragma unroll
        for (int kt = 0; kt < 2; ++kt) {
#pragma unroll
            for (int sT = 0; sT <= tT; ++sT) { const int ti = sT + tT;
#pragma unroll
                for (int hf = 0; hf < 2; ++hf) Z[kt] = __builtin_amdgcn_mfma_f32_32x32x16_bf16(arp[ti][hf], Wpk[sT][kt][hf], Z[kt], 0, 0, 0); }
#pragma unroll
            for (int hf = 0; hf < 2; ++hf) Z[kt] = __builtin_amdgcn_mfma_f32_32x32x16_bf16(Ipk[hf], RW_VTR(rd1, kt, 2 * tT + hf), Z[kt], 0, 0, 0); }
        { const int zo = 256 + (32 * tT + 4 * hi) * PINP + r32;
#pragma unroll
          for (int r = 0; r < 16; ++r) { const int ro = zo + ((r & 3) + 8 * (r >> 2)) * PINP; PRr[ro] = (bf16)f2bf(Z[0][r]); PRr[ro + 32] = (bf16)f2bf(Z[1][r]); } } }
#endif
#if RWC_STAGE >= 4
    RW_FENCE();
    rw_image(buf1, Bb, r32, hi);
    { bf16* po = (bf16*)((unsigned char*)F.out + CRW_P) + item * 4096;
#pragma unroll
      for (int kt = 0; kt < 2; ++kt)
#pragma unroll
          for (int k2 = 0; k2 < 2; ++k2) { f32x16 acc = f32x16{};
#pragma unroll
              for (int blk = 0; blk < 4; ++blk) acc = __builtin_amdgcn_mfma_f32_32x32x16_bf16(RW_VTR(rd1, kt, blk), Wpk[blk >> 1][k2][blk & 1], acc, 0, 0, 0);
              const int po_ = (32 * kt + 4 * hi) * 64 + 32 * k2 + r32, dg = (kt == k2) ? r32 - 4 * hi : -1;
#pragma unroll
              for (int r = 0; r < 16; ++r) po[po_ + ((r & 3) + 8 * (r >> 2)) * 64] = (bf16)f2bf((acc[r] + (((r & 3) + 8 * (r >> 2)) == dg ? 1.f : 0.f)) * __expf(bend[(2 * kt + (r >> 3)) * 8 + (r & 7)])); } }
#endif
#undef RW_FENCE
#undef RW_PARK
}
__device__ __forceinline__ void scan_phase(Frame& F, const Args& A, int l) {
    const int gw = F.wave * F.G + (int)blockIdx.x;
    const int NGW = NWAVES * F.G;
    for (int it = gw; it < 32 * (NSR + NSH + NSG); it += NGW) {
        if (it < 32 * NSR) { const int sh = it / NSR;
#if RWC_STAGE < 4
            scan_rwkv(F, A, l, sh >> 2, sh & 3, it % NSR);
#endif
            rwkv_chunk(F, A, l, sh >> 2, sh & 3, it % NSR); }
        else if (it < 32 * (NSR + NSH)) { const int i2 = it - 32 * NSR, sh = i2 / NSH; chunk_scan<64, false>(F, sh >> 2, sh & 3, i2 % NSH); }
        else { const int i2 = it - 32 * (NSR + NSH), sh = i2 / NSG; chunk_scan<32, true>(F, sh >> 2, sh & 3, i2 % NSG); }
    }
}
__device__ __forceinline__ void carry_phase(Frame& F) {
    const int blk = (int)blockIdx.x, w = F.wave, lane = F.lane, r32 = lane & 31, hi = lane >> 5;
    unsigned char* X2b = (unsigned char*)F.out;
    if (blk < 32) {
        const int sh = blk, i = (w >> 1) & 1, jv = w & 1;
        LAS unsigned char* Sb = F.lds + RING_OFF;
        LAS unsigned char* Ab = Sb + 2 * 9216;
        for (int idx = F.tid; idx < 2 * 64 * 144 / 4; idx += NWAVES * 64) ((LAS unsigned*)Sb)[idx] = 0u;
        bf16* ST = (bf16*)(X2b + CRW_T) + (size_t)sh * NSR * 4096;
        constexpr int CPD = 16;
        static_assert(NSR % CPD == 0, "chain length");
        if (w < 4) {
            const v4u* SL4 = (const v4u*)(X2b + CRW_S) + (size_t)sh * NSR * 512 + ((i * 2 + jv) * 64 + lane) * 2;
            v4u aq[CPD][2];
#define CY_LOAD(u, jj) do { const int jn_ = ((jj) < NSR - 1) ? (jj) : NSR - 2; \
            _Pragma("unroll") for (int q = 0; q < 2; ++q) aq[u][q] = SL4[(size_t)jn_ * 512 + q]; } while (0)
#pragma unroll
            for (int u = 0; u < CPD; ++u) CY_LOAD(u, u);
            asm volatile("s_waitcnt lgkmcnt(0)\n\ts_barrier" ::: "memory");
            for (int j0 = 0; j0 < NSR; j0 += CPD) {
#pragma unroll
                for (int u = 0; u < CPD; ++u) { const int j = j0 + u;
                    LAS unsigned char* Sr = Sb + (u & 1) * 9216; LAS unsigned char* Sw = Sb + ((u + 1) & 1) * 9216; LAS unsigned char* Ar = Ab + (u & 1) * 9216;
                    f32x16 acc;
#pragma unroll
                    for (int q = 0; q < 2; ++q) { const unsigned d0 = aq[u][q].x, d1 = aq[u][q].y, d2 = aq[u][q].z, d3 = aq[u][q].w;
                        acc[8 * q] = __builtin_bit_cast(float, d0 << 16); acc[8 * q + 1] = __builtin_bit_cast(float, d0 & 0xffff0000u); acc[8 * q + 2] = __builtin_bit_cast(float, d1 << 16); acc[8 * q + 3] = __builtin_bit_cast(float, d1 & 0xffff0000u);
                        acc[8 * q + 4] = __builtin_bit_cast(float, d2 << 16); acc[8 * q + 5] = __builtin_bit_cast(float, d2 & 0xffff0000u); acc[8 * q + 6] = __builtin_bit_cast(float, d3 << 16); acc[8 * q + 7] = __builtin_bit_cast(float, d3 & 0xffff0000u); }
#pragma unroll
                    for (int kk = 0; kk < 4; ++kk) {
                        const bf16x8 afr = *(const LAS bf16x8*)(Ar + (32 * i + r32) * 144 + (16 * kk + 8 * hi) * 2);
                        const bf16x8 bfr = *(const LAS bf16x8*)(Sr + (32 * jv + r32) * 144 + (16 * kk + 8 * hi) * 2);
                        acc = __builtin_amdgcn_mfma_f32_32x32x16_bf16(afr, bfr, acc, 0, 0, 0);
                    }
                    CY_LOAD(u, j + CPD);
#pragma unroll
                    for (int q = 0; q < 4; ++q) { const int k = 32 * i + 8 * q + 4 * hi;
                        *(LAS unsigned long long*)(Sw + (32 * jv + r32) * 144 + k * 2) = (unsigned long long)pk2(acc[4 * q], acc[4 * q + 1]) | ((unsigned long long)pk2(acc[4 * q + 2], acc[4 * q + 3]) << 32); }
                    asm volatile("s_waitcnt lgkmcnt(0)\n\ts_barrier" ::: "memory");
                }
            }
#undef CY_LOAD
        } else {
            const int t = (w - 4) * 64 + lane, row = t >> 2, ch = t & 3;
            const v4u* PTg = (const v4u*)((const bf16*)(X2b + CRW_P) + (size_t)sh * NSR * 4096 + row * 64 + ch * 16);
            v4u pq[CPD][2];
#define CP_LOAD(u, jj) do { const int jn_ = ((jj) < NSR - 1) ? (jj) : NSR - 2; pq[u][0] = PTg[(size_t)jn_ * 512]; pq[u][1] = PTg[(size_t)jn_ * 512 + 1]; } while (0)
#pragma unroll
            for (int u = 0; u < CPD; ++u) CP_LOAD(u, u);
            { LAS unsigned char* Aw = Ab + row * 144 + ch * 32; *(LAS v4u*)Aw = pq[0][0]; *(LAS v4u*)(Aw + 16) = pq[0][1]; }
            CP_LOAD(0, CPD);
            asm volatile("s_waitcnt lgkmcnt(0)\n\ts_barrier" ::: "memory");
            for (int j0 = 0; j0 < NSR; j0 += CPD) {
#pragma unroll
                for (int u = 0; u < CPD; ++u) { const int j = j0 + u; constexpr int dmy_ = 0; (void)dmy_;
                    { LAS unsigned char* Aw = Ab + ((u + 1) & 1) * 9216 + row * 144 + ch * 32;
                      *(LAS v4u*)Aw = pq[(u + 1) % CPD][0]; *(LAS v4u*)(Aw + 16) = pq[(u + 1) % CPD][1]; }
                    CP_LOAD((u + 1) % CPD, j + 1 + CPD);
                    asm volatile("s_waitcnt lgkmcnt(0)\n\ts_barrier" ::: "memory");
                    const LAS unsigned char* Sw = Sb + ((u + 1) & 1) * 9216 + row * 144 + ch * 32;
                    const v4u x0 = *(const LAS v4u*)Sw, x1 = *(const LAS v4u*)(Sw + 16);
                    const int jst = (j + 1) & (NSR - 1);
                    v4u* dst = (v4u*)(ST + (size_t)jst * 4096 + row * 64 + ch * 16);
                    dst[0] = x0; dst[1] = x1; }
            }
#undef CP_LOAD
        }
    } else if (blk < 64) {
        const int sh = blk - 32;
        float s[8];
#pragma unroll
        for (int e = 0; e < 8; ++e) s[e] = 0.f;
        const float* SL = (const float*)(X2b + CH_S) + (size_t)sh * NSH * 4096 + (8 * w) * 64 + lane; const float* GG = (const float*)(X2b + CH_G) + (size_t)sh * NSH * 64 + 8 * w;
        bf16* ST = (bf16*)(X2b + CH_T) + (size_t)sh * NSH * 4096 + lane * 64 + 8 * w;
        for (int j0 = 0; j0 < NSH; j0 += 8) {
            float gq[8][8], lq[8][8]; v4u o[8];
#pragma unroll
            for (int u = 0; u < 8; ++u) { const int jn = (j0 + u < NSH - 1) ? j0 + u : NSH - 2;
#pragma unroll
                for (int e = 0; e < 8; ++e) { gq[u][e] = GG[jn * 64 + e]; lq[u][e] = SL[(size_t)jn * 4096 + e * 64]; } }
#pragma unroll
            for (int u = 0; u < 8; ++u) {
#pragma unroll
                for (int e = 0; e < 8; ++e) s[e] = gq[u][e] * s[e] + lq[u][e];
                o[u].x = pk2(s[0], s[1]); o[u].y = pk2(s[2], s[3]); o[u].z = pk2(s[4], s[5]); o[u].w = pk2(s[6], s[7]); }
#pragma unroll
            for (int u = 0; u < 8; ++u) *(v4u*)(ST + (size_t)((j0 + u + 1) & (NSH - 1)) * 4096) = o[u];
        }
    } else if (blk < 96) {
        const int sh = blk - 64;
        float s[4];
#pragma unroll
        for (int e = 0; e < 4; ++e) s[e] = 0.f;
        const float* SL = (const float*)(X2b + CG_S) + (size_t)sh * NSG * 2048 + (4 * w) * 64 + lane; const float* GG = (const float*)(X2b + CG_G) + (size_t)sh * NSG * 32 + 4 * w;
        bf16* ST = (bf16*)(X2b + CG_T) + (size_t)sh * NSG * 2048 + lane * 32 + 4 * w;
        for (int j0 = 0; j0 < NSG; j0 += 8) {
            float gq[8][4], lq[8][4]; unsigned long long o[8];
#pragma unroll
            for (int u = 0; u < 8; ++u) { const int jn = (j0 + u < NSG - 1) ? j0 + u : NSG - 2;
#pragma unroll
                for (int e = 0; e < 4; ++e) { gq[u][e] = GG[jn * 32 + e]; lq[u][e] = SL[(size_t)jn * 2048 + e * 64]; } }
#pragma unroll
            for (int u = 0; u < 8; ++u) {
#pragma unroll
                for (int e = 0; e < 4; ++e) s[e] = gq[u][e] * s[e] + lq[u][e];
                o[u] = (unsigned long long)pk2(s[0], s[1]) | ((unsigned long long)pk2(s[2], s[3]) << 32); }
#pragma unroll
            for (int u = 0; u < 8; ++u) *(unsigned long long*)(ST + (size_t)((j0 + u + 1) & (NSG - 1)) * 2048) = o[u];
        }
    }
}
template <int K> __device__ __forceinline__ void fix_tile(const bf16* z, int zpitch, bf16* y, const bf16* ST, int lane) {
    const int r32 = lane & 31, hi = lane >> 5;
    bf16x8 a[K / 16];
#pragma unroll
    for (int kk = 0; kk < K / 16; ++kk) a[kk] = *(const bf16x8*)(z + (size_t)r32 * zpitch + 16 * kk + 8 * hi);
#pragma unroll
    for (int jv = 0; jv < 2; ++jv) {
        f32x16 acc;
#pragma unroll
        for (int r = 0; r < 16; ++r) acc[r] = bf2f(y[(size_t)att::crow(r, hi) * PINP + 32 * jv + r32]);
#pragma unroll
        for (int kk = 0; kk < K / 16; ++kk) { const bf16x8 bb = *(const bf16x8*)(ST + (32 * jv + r32) * K + 16 * kk + 8 * hi); acc = __builtin_amdgcn_mfma_f32_32x32x16_bf16(a[kk], bb, acc, 0, 0, 0); }
#pragma unroll
        for (int r = 0; r < 16; ++r) y[(size_t)att::crow(r, hi) * PINP + 32 * jv + r32] = (bf16)f2bf(acc[r]);
    }
}
__device__ __forceinline__ void fixup_phase(Frame& F) {
    const int gw = F.vcu * NWAVES + F.wave, NGW = F.G * NWAVES, lane = F.lane;
    unsigned char* X2b = (unsigned char*)F.out;
    constexpr int PR_R = (NSR - 1) * (LR / 32), PR_H = (NSH - 1) * (LH / 32), PR_G = (NSG - 1) * (LG / 32);
    constexpr int NI_R = 32 * PR_R, NI_H = 32 * PR_H, NI_G = 32 * PR_G;
    for (int it = gw; it < NI_R + NI_H + NI_G; it += NGW) {
        if (it < NI_R) { const int sh = it / PR_R, rem = it % PR_R, seg = 1 + rem / (LR / 32), tt = rem % (LR / 32);
            const size_t m0 = (size_t)(sh >> 2) * SEQ + seg * LR + tt * 32; const int h = sh & 3;
            fix_tile<64>(((bf16*)(F.ws + WS_PR)) + m0 * PINP + SD0 + 256 + h * 64, PINP, ((bf16*)(F.ws + WS_PR)) + m0 * PINP + SD0 + h * 64, (const bf16*)(X2b + CRW_T) + (size_t)(sh * NSR + seg) * 4096, lane); }
        else if (it < NI_R + NI_H) { const int i2 = it - NI_R, sh = i2 / PR_H, rem = i2 % PR_H, seg = 1 + rem / (LH / 32), tt = rem % (LH / 32);
            const size_t m0 = (size_t)(sh >> 2) * SEQ + seg * LH + tt * 32; const int h = sh & 3;
            fix_tile<64>(((bf16*)(F.ws + WS_PR)) + m0 * PINP + SC0 + 256 + h * 64, PINP, ((bf16*)(F.ws + WS_PR)) + m0 * PINP + SC0 + h * 64, (const bf16*)(X2b + CH_T) + (size_t)(sh * NSH + seg) * 4096, lane); }
        else { const int i2 = it - NI_R - NI_H, sh = i2 / PR_G, rem = i2 % PR_G, seg = 1 + rem / (LG / 32), tt = rem % (LG / 32);
            const size_t m0 = (size_t)(sh >> 2) * SEQ + seg * LG + tt * 32; const int h = sh & 3;
            fix_tile<32>(((bf16*)(F.ws + WS_ZG)) + m0 * 128 + h * 32, 128, ((bf16*)(F.ws + WS_PR)) + m0 * PINP + SB0 + h * 64, (const bf16*)(X2b + CG_T) + (size_t)(sh * NSG + seg) * 2048, lane); }
    }
}
__device__ __forceinline__ void finalize_phase(Frame& F, const Args& A, int l) {
    LAS unsigned char* sgb = F.lds + RING_OFF;
    LAS float* gl = (LAS float*)(F.lds + RING_OFF + 8192);
    LAS bf16* fixl = (LAS bf16*)(F.lds + RING_OFF + 8192 + 32768);
    unsigned char* CB = (unsigned char*)F.out;
    const int tid = F.tid, c = tid & 255, th = __builtin_amdgcn_readfirstlane(tid >> 8), h = __builtin_amdgcn_readfirstlane(c >> 6);
    const float* mu = A.in[15] + l * 896;
    const float gla_g = A.in[12][l * 64 + (c & 63)], hg_g = A.in[14][l * 64 + (c & 63)], lng = A.in[24][l * 256 + c], lnb = A.in[25][l * 256 + c], mu_v = mu[512 + c];
    const int r32 = F.lane & 31, hi = F.lane >> 5, wv = F.wave;
    bf16x8 bgu[4];
#pragma unroll
    for (int kk = 0; kk < 4; ++kk)
#pragma unroll
        for (int i = 0; i < 8; ++i) bgu[kk][i] = (short)f2bf(A.in[20][(l * 64 + 16 * kk + 8 * hi + i) * 256 + 32 * wv + r32]);
    const int mxA = wv >> 2, hhA = wv & 3;
    const int c4 = 4 * F.lane, hl = F.lane >> 4;
    const f32x4 glag4 = *(const f32x4*)(A.in[12] + l * 64 + (c4 & 63)), hgg4 = *(const f32x4*)(A.in[14] + l * 64 + (c4 & 63)), lng4 = *(const f32x4*)(A.in[24] + l * 256 + c4), lnb4 = *(const f32x4*)(A.in[25] + l * 256 + c4), muv4 = *(const f32x4*)(mu + 512 + c4);
    bf16 s1r[4], s1p[4];
    bf16x8 afA[4], b0A[4], b1A[4], afB[2], b0B[2], b1B[2];
    u32x2 i_oa[4], i_yb[4], i_ogb[4], i_yc[4], i_ogc[4], i_yd[4], i_vr[4], i_vp[4]; float i_bs[4];
#define FI_LOADT(k, M0) do { const int tok_ = 4 * wv + (k), t_ = (M0) % SEQ + tok_; const size_t m_ = (size_t)(M0) + tok_; const bf16* row = ((bf16*)(F.ws + WS_PR)) + m_ * PINP + c4; \
        i_oa[k] = *(const u32x2*)(row + SA0); i_yb[k] = *(const u32x2*)(row + SB0); i_ogb[k] = *(const u32x2*)(row + SB0 + 528); i_yc[k] = *(const u32x2*)(row + SC0); i_ogc[k] = *(const u32x2*)(row + SC0 + 768); \
        i_yd[k] = *(const u32x2*)(row + SD0); i_vr[k] = *(const u32x2*)(row + SD0 + 512); i_vp[k] = *(const u32x2*)(row + SD0 + 512 - (t_ > 0 ? PINP : 0)); i_bs[k] = ((float*)(F.ws + WS_BS))[m_ * 4 + hl]; } while (0)
#define FI_HEAD(M0) do { const int m0_ = (M0), t0_ = m0_ % SEQ, bq_ = m0_ / SEQ; \
        _Pragma("unroll") for (int e = 0; e < 4; ++e) { const int idx = tid * 4 + e, i = idx >> 6, j = idx & 63; const size_t m = (size_t)m0_ + i; \
            s1r[e] = ((bf16*)(F.ws + WS_PR))[m * PINP + SD0 + 832 + j]; s1p[e] = ((bf16*)(F.ws + WS_PR))[(m - (t0_ + i > 0 ? 1 : 0)) * PINP + SD0 + 832 + j]; } \
        { const int sh = bq_ * 4 + hhA; \
          const bf16* zp = ((bf16*)(F.ws + WS_PR)) + ((size_t)m0_ + r32) * PINP + (mxA == 0 ? SD0 : SC0) + 256 + hhA * 64; \
          const bf16* stp = (mxA == 0) ? (const bf16*)(CB + CRW_T) + (size_t)(sh * NSR + t0_ / LR) * 4096 : (const bf16*)(CB + CH_T) + (size_t)(sh * NSH + t0_ / LH) * 4096; \
          _Pragma("unroll") for (int kk = 0; kk < 4; ++kk) { afA[kk] = *(const bf16x8*)(zp + 16 * kk + 8 * hi); b0A[kk] = *(const bf16x8*)(stp + r32 * 64 + 16 * kk + 8 * hi); b1A[kk] = *(const bf16x8*)(stp + (32 + r32) * 64 + 16 * kk + 8 * hi); } \
        } } while (0)
#define BF4(v, o) do { o[0] = __builtin_bit_cast(float, (v).x << 16); o[1] = __builtin_bit_cast(float, (v).x & 0xffff0000u); o[2] = __builtin_bit_cast(float, (v).y << 16); o[3] = __builtin_bit_cast(float, (v).y & 0xffff0000u); } while (0)
#define ROW16(v) do { v += dppf<0xB1>(v); v += dppf<0x4E>(v); v += dppf<0x141>(v); v += dppf<0x140>(v); } while (0)
#define FI_STAGE1(M0) do { const int t0s_ = (M0) % SEQ; \
        _Pragma("unroll") for (int e = 0; e < 4; ++e) { const int idx = tid * 4 + e, i = idx >> 6, j = idx & 63; \
            const float raw = bf2f(s1r[e]); const float prev = (t0s_ + i > 0) ? bf2f(s1p[e]) : 0.f; \
            *(LAS bf16*)(sgb + i * 144 + j * 2) = (bf16)f2bf(sigmoidf_(raw + mu[832 + j] * (prev - raw))); } } while (0)
    if (F.vcu < M / 32) { FI_HEAD(F.vcu * 32);
#pragma unroll
        for (int k = 0; k < 4; ++k) FI_LOADT(k, F.vcu * 32);
        FI_STAGE1(F.vcu * 32); }
    for (int u = F.vcu; u < M / 32; u += F.G) {
        const int m0 = u * 32, t0 = m0 % SEQ;
        const int segR = t0 / LR, segH = t0 / LH, segG = t0 / LG;
        { const bf16* zq = ((bf16*)(F.ws + WS_ZG)) + ((size_t)m0 + r32) * 128 + hhA * 32;
          const bf16* stq = (const bf16*)(CB + CG_T) + (size_t)((m0 / SEQ * 4 + hhA) * NSG + segG) * 2048;
#pragma unroll
          for (int kk = 0; kk < 2; ++kk) { afB[kk] = *(const bf16x8*)(zq + 16 * kk + 8 * hi); b0B[kk] = *(const bf16x8*)(stq + r32 * 32 + 16 * kk + 8 * hi); b1B[kk] = *(const bf16x8*)(stq + (32 + r32) * 32 + 16 * kk + 8 * hi); } }
        LDS_BAR();
        { f32x16 cgv = {};
#pragma unroll
          for (int kk = 0; kk < 4; ++kk) { const bf16x8 ag = *(const LAS bf16x8*)(sgb + r32 * 144 + (16 * kk + 8 * hi) * 2); cgv = __builtin_amdgcn_mfma_f32_32x32x16_bf16(ag, bgu[kk], cgv, 0, 0, 0); }
#pragma unroll
          for (int r = 0; r < 16; ++r) gl[att::crow(r, hi) * 256 + 32 * wv + r32] = cgv[r]; }
        if ((mxA == 0 ? segR : segH) > 0) {
            f32x16 c0 = {}, c1 = {};
#pragma unroll
            for (int kk = 0; kk < 4; ++kk) { c0 = __builtin_amdgcn_mfma_f32_32x32x16_bf16(afA[kk], b0A[kk], c0, 0, 0, 0); c1 = __builtin_amdgcn_mfma_f32_32x32x16_bf16(afA[kk], b1A[kk], c1, 0, 0, 0); }
            LAS bf16* fo = fixl + mxA * 8192 + hhA * 64 + r32;
#pragma unroll
            for (int r = 0; r < 16; ++r) { fo[att::crow(r, hi) * 256] = (bf16)f2bf(c0[r]); fo[att::crow(r, hi) * 256 + 32] = (bf16)f2bf(c1[r]); }
        }
        if (wv < 4 && segG > 0) {
            f32x16 c0 = {}, c1 = {};
#pragma unroll
            for (int kk = 0; kk < 2; ++kk) { c0 = __builtin_amdgcn_mfma_f32_32x32x16_bf16(afB[kk], b0B[kk], c0, 0, 0, 0); c1 = __builtin_amdgcn_mfma_f32_32x32x16_bf16(afB[kk], b1B[kk], c1, 0, 0, 0); }
            LAS bf16* fo = fixl + 2 * 8192 + hhA * 64 + r32;
#pragma unroll
            for (int r = 0; r < 16; ++r) { fo[att::crow(r, hi) * 256] = (bf16)f2bf(c0[r]); fo[att::crow(r, hi) * 256 + 32] = (bf16)f2bf(c1[r]); }
        }
        LDS_BAR();
        const int un = (u + F.G < M / 32) ? u + F.G : u;
        FI_HEAD(un * 32);
#pragma unroll
        for (int k = 0; k < 4; ++k) {
            const int tok = 4 * wv + k;
            float yb[4], ogb[4], yc[4], ogc[4], yd[4], vr[4], vp[4], fx[4];
            BF4(i_yb[k], yb); BF4(i_ogb[k], ogb); BF4(i_yc[k], yc); BF4(i_ogc[k], ogc); BF4(i_yd[k], yd); BF4(i_vr[k], vr); BF4(i_vp[k], vp);
            if (segG > 0) { const u32x2 f2 = *(const LAS u32x2*)(fixl + 2 * 8192 + tok * 256 + c4); BF4(f2, fx);
#pragma unroll
                for (int e = 0; e < 4; ++e) yb[e] += fx[e]; }
            if (segH > 0) { const u32x2 f2 = *(const LAS u32x2*)(fixl + 8192 + tok * 256 + c4); BF4(f2, fx);
#pragma unroll
                for (int e = 0; e < 4; ++e) yc[e] += fx[e]; }
            if (segR > 0) { const u32x2 f2 = *(const LAS u32x2*)(fixl + tok * 256 + c4); BF4(f2, fx);
#pragma unroll
                for (int e = 0; e < 4; ++e) yd[e] += fx[e]; }
            const f32x4 g4 = *(const LAS f32x4*)(gl + tok * 256 + c4);
            float sb = (yb[0] * yb[0] + yb[1] * yb[1]) + (yb[2] * yb[2] + yb[3] * yb[3]), sc = (yc[0] * yc[0] + yc[1] * yc[1]) + (yc[2] * yc[2] + yc[3] * yc[3]), sd = (yd[0] + yd[1]) + (yd[2] + yd[3]);
            ROW16(sb); ROW16(sc); ROW16(sd);
            const float rb = RS_EPS(sb, 1.f / 64.f, 64e-6f), rc = RS_EPS(sc, 1.f / 64.f, 64e-6f), mean = sd * (1.f / 64.f);
            float dy[4];
#pragma unroll
            for (int e = 0; e < 4; ++e) dy[e] = yd[e] - mean;
            float var = (dy[0] * dy[0] + dy[1] * dy[1]) + (dy[2] * dy[2] + dy[3] * dy[3]);
            ROW16(var);
            const float rd = RS_EPS(var, 1.f / 64.f, 64.f * 64e-5f);
            const bool t_pos = (t0 + tok > 0);
            float ob[4], oc[4], od[4];
#pragma unroll
            for (int e = 0; e < 4; ++e) {
                ob[e] = yb[e] * rb * glag4[e] * ogb[e] * sigmoidf_(ogb[e]);
                oc[e] = yc[e] * rc * hgg4[e] * ogc[e] * sigmoidf_(ogc[e]);
                const float yn = dy[e] * rd * lng4[e] + lnb4[e];
                const float vpv = t_pos ? vp[e] : 0.f;
                const float v = vr[e] + muv4[e] * (vpv - vr[e]);
                od[e] = (yn + i_bs[k] * v) * g4[e];
            }
            bf16* row = ((bf16*)(F.ws + WS_PR)) + ((size_t)m0 + tok) * PINP + SC0 + c4;
            u32x2 w;
            *(u32x2*)row = i_oa[k];
            w.x = pk2(ob[0], ob[1]); w.y = pk2(ob[2], ob[3]); *(u32x2*)(row + 256) = w;
            w.x = pk2(oc[0], oc[1]); w.y = pk2(oc[2], oc[3]); *(u32x2*)(row + 512) = w;
            w.x = pk2(od[0], od[1]); w.y = pk2(od[2], od[3]); *(u32x2*)(row + 768) = w;
            FI_LOADT(k, un * 32);
        }
        FI_STAGE1(un * 32);
    }
#undef FI_STAGE1
#undef FI_LOADT
#undef FI_HEAD
#undef BF4
#undef ROW16
}
__global__ void __launch_bounds__(NWAVES * 64, 2) fwd_kernel(Args args) {
    extern __shared__ __attribute__((aligned(16))) unsigned char lds[];
    Frame F;
    F.lds = (LAS unsigned char*)lds;
    F.MISC = (volatile LAS unsigned*)(F.lds + MISC_OFF);
    F.tid = threadIdx.x; F.lane = F.tid & 63; F.wave = __builtin_amdgcn_readfirstlane(F.tid >> 6);
    const int wave0_ = F.wave;
    F.G = gridDim.x; { const int bx = blockIdx.x; F.vcu = (F.G % 8 == 0) ? (bx % 8) * (F.G / 8) + bx / 8 : bx; }
    unsigned char* ws = args.ws; F.ws = ws; F.out = args.out;
    F.ctl = (gu32*)(ws + WS_CTL);
    for (int u = F.tid; u < (LDS_BYTES - LDSCTL_OFF) / 4; u += NWAVES * 64) ((LAS unsigned*)(F.lds + LDSCTL_OFF))[u] = 0u;
    __syncthreads();
    XcdBarrier bar = xcd_barrier_post((unsigned*)(F.ctl + CW_BAR), F.MISC + 8);
    bar.wv = F.wave;
    int bid = (int)blockIdx.x;
#define RELAUNDER() do { int t_ = wave0_ * 64 + LANE_ID(); asm volatile("" : "+v"(t_)); F.tid = t_; F.lane = t_ & 63; F.wave = wave0_; \
    int b_ = blockIdx.x; asm volatile("" : "+s"(b_)); bid = b_; F.vcu = (F.G % 8 == 0) ? (b_ % 8) * (F.G / 8) + b_ / 8 : b_; } while (0)
#define GRID_BAR() do { XcdBarrier bb_ = bar; asm volatile("" : "+s"(bb_.x)); xcd_barrier(bb_); RELAUNDER(); } while (0)

#ifndef NO_P0
    p0_prologue(F, args);
    float* SSb = (float*)(ws + WS_SS);
    x0_phase(F, args.in[0], ((bf16*)(F.ws + WS_X2)), SSb);
#endif
    GRID_BAR();
    for (int l = 0; l < NL; ++l) {
        { pg8::Gemm g{((bf16*)(F.ws + WS_X2)), (const bf16*)(ws + WS_WI) + (size_t)l * PINP * D, M, PINP, D, D}; pg8::StaticOrder S; S.init(M, PINP, F.G, bid);
          pg8::EpiInProj E{((bf16*)(F.ws + WS_PR)), PINP, args.in[3] + l * 32, args.in[4] + l * 32, SSb + (size_t)(2 * l) * M * 16};
          pg8::gemm_phase<pg8::EpiInProj, pg8::StaticOrder, true, true>(F.lds + RING_OFF, g, S, E, F.wave); }
        GRID_BAR();
        prep_scalars(F, args, l);
        GRID_BAR();
        scan_phase(F, args, l);
        { XcdBarrier bb_ = bar; asm volatile("" : "+s"(bb_.x)); xcd_split_arrive(bb_, (unsigned*)(F.ctl + CW_SBAR), (unsigned)l); RELAUNDER(); }
        attn_phase(F, args, l, (char*)lds + RING_OFF);
        if (bid < 96) { { XcdBarrier bb_ = bar; asm volatile("" : "+s"(bb_.x)); xcd_split_wait(bb_, (unsigned*)(F.ctl + CW_SBAR), (unsigned)l); RELAUNDER(); }
            carry_phase(F); }
        GRID_BAR();
#ifndef NO_FI
        finalize_phase(F, args, l);
#endif
        GRID_BAR();
        { pg8::Gemm g{((bf16*)(F.ws + WS_PR)) + SC0, (const bf16*)(ws + WS_WO) + (size_t)l * D * D, M, D, D, PINP}; pg8::StaticOrder S; S.init(M, D, F.G, bid);
          pg8::EpiResidB<false> E{((bf16*)(F.ws + WS_X2)), F.out, SSb + (size_t)(2 * l + 1) * M * 16, D};
          pg8::gemm_phase<pg8::EpiResidB<false>, pg8::StaticOrder, true, true>(F.lds + RING_OFF, g, S, E, F.wave); }
        GRID_BAR();
        { pg8::Gemm g{((bf16*)(F.ws + WS_X2)), (const bf16*)(ws + WS_WU) + (size_t)l * FF * D, M, FF, D, D}; pg8::StaticOrder S; S.init(M, FF, F.G, bid);
          pg8::EpiStoreBf16<1> E{((bf16*)(F.ws + WS_H)), FF, SSb + (size_t)(2 * l + 1) * M * 16};
          pg8::gemm_phase<pg8::EpiStoreBf16<1>, pg8::StaticOrder, true, true>(F.lds + RING_OFF, g, S, E, F.wave); }
        GRID_BAR();
        { pg8::Gemm g{((bf16*)(F.ws + WS_H)), (const bf16*)(ws + WS_WD) + (size_t)l * D * FF, M, D, FF, FF}; pg8::StaticOrder S; S.init(M, D, F.G, bid);
          if (l < NL - 1) { pg8::EpiResidB<false> E{((bf16*)(F.ws + WS_X2)), F.out, SSb + (size_t)(2 * l + 2) * M * 16, D};
            pg8::gemm_phase<pg8::EpiResidB<false>, pg8::StaticOrder, true, true>(F.lds + RING_OFF, g, S, E, F.wave); }
          else { pg8::EpiResidB<true> E{((bf16*)(F.ws + WS_X2)), F.out, SSb, D};
            pg8::gemm_phase<pg8::EpiResidB<true>, pg8::StaticOrder, true, true>(F.lds + RING_OFF, g, S, E, F.wave); } }
        GRID_BAR();
    }
}

extern "C" void kernel_launch(void* const* d_in, const int* in_sizes, int n_in, void* d_out, int out_size, void* d_ws, size_t ws_size, hipStream_t stream) {
    static int grid = 0;
    if (grid == 0) {
        if (n_in != 30 || out_size != M * D || ws_size < WS_END) { fprintf(stderr, "kernel_launch: unexpected shapes (n_in %d, out %d, ws %zu < %zu)\n", n_in, out_size, ws_size, (size_t)WS_END); grid = -1; return; }
        int dev = 0, cus = 0, per_cu = 0;
        if (hipGetDevice(&dev) != hipSuccess || hipDeviceGetAttribute(&cus, hipDeviceAttributeMultiprocessorCount, dev) != hipSuccess) { grid = -1; return; }
        if (hipFuncSetAttribute((const void*)fwd_kernel, hipFuncAttributeMaxDynamicSharedMemorySize, LDS_BYTES) != hipSuccess) { fprintf(stderr, "kernel_launch: hipFuncSetAttribute failed\n"); grid = -1; return; }
        if (hipOccupancyMaxActiveBlocksPerMultiprocessor(&per_cu, (const void*)fwd_kernel, NWAVES * 64, LDS_BYTES) != hipSuccess || per_cu < 1)
            fprintf(stderr, "kernel_launch: occupancy query reports %d blocks per CU\n", per_cu);
        (void)hipGetLastError();
        grid = cus;
    }
    if (grid < 0) return;
    if (hipMemsetAsync((char*)d_ws + WS_CTL, 0, CTL_ZERO_BYTES, stream) != hipSuccess) return;
    Args a{};
    for (int i = 0; i < 30; ++i) a.in[i] = (const float*)d_in[i];
    a.out = (float*)d_out; a.ws = (unsigned char*)d_ws;
    hipLaunchKernelGGL(fwd_kernel, dim3(grid), dim3(NWAVES * 64), LDS_BYTES, stream, a);
}
```

```cpp
#define RWC_STAGE 4
#include <hip/hip_runtime.h>
#include <cstdio>
#include <cstdint>
#include <cmath>
#define LANE_ID() ({ unsigned m_ = ~0u; asm volatile("" : "+s"(m_)); (int)__builtin_amdgcn_mbcnt_hi(m_, __builtin_amdgcn_mbcnt_lo(m_, 0u)); })
#define RS_EPS(sum, inv_n, eps_n) ({ float t_ = (sum) + (eps_n); asm volatile("" : "+v"(t_)); __builtin_amdgcn_rsqf(t_ * (inv_n)); })
namespace pg8 {
#define PG8_LAS __attribute__((address_space(3)))
typedef unsigned short bf16_t;
typedef short bf16x8 __attribute__((ext_vector_type(8)));
typedef float f32x4 __attribute__((ext_vector_type(4)));
typedef unsigned u32x4 __attribute__((ext_vector_type(4)));
constexpr int BM = 256, BK = 64, HALF = 128, HTB = HALF * BK * 2  , STAGE_BYTES = 8 * HTB, NXCD = 8, WGM = 8;

__host__ __device__ __forceinline__ int lds_byte(int r, int c) { const int st = (r >> 4) * 2 + (c >> 5), rr = r & 15, cc = c & 31, ob = rr * 64 + cc * 2; return st * 1024 + (ob ^ (((ob >> 9) & 1) << 5)); }
__host__ __device__ __forceinline__ void stage_rc(int b, int& R, int& C) { const int st = b / 1024, sb = b % 1024, swz = sb ^ (((sb >> 9) & 1) << 5); R = (st >> 1) * 16 + swz / 64; C = (st & 1) * 32 + (swz % 64) / 2; }
__host__ __device__ __forceinline__ int perm32(int rho) { const int n = rho >> 4, i = rho & 15; return 8 * (i >> 2) + 4 * n + (i & 3); }

struct Unit { int pm, pn; };
struct Gemm { const bf16_t* A; const bf16_t* Bt; int M, N, K, lda; };

struct StaticOrder {
    int nM, nN, nwg, G, c;
    __host__ __device__ void init(int M, int N, int G_, int c_) { nM = M / BM; nN = N / BM; nwg = nM * nN; G = G_; c = c_; }
    __host__ __device__ bool next(int i, Unit& u) const {
        const long L = (long)i * G + c; if (L >= nwg) return false;
        int wgid = (int)L; { const int q = nwg / NXCD, r = nwg % NXCD, xcd = wgid % NXCD, off = wgid / NXCD; wgid = (xcd < r ? xcd * (q + 1) : r * (q + 1) + (xcd - r) * q) + off; }
        const int nig = WGM * nN, gid = wgid / nig, fm = gid * WGM, gsz = (nM - fm) < WGM ? (nM - fm) : WGM;
        u.pm = fm + ((wgid % nig) % gsz); u.pn = (wgid % nig) / gsz; return true;
    }
    __device__ __forceinline__ void a_ready(const Unit&) const {}
    __device__ __forceinline__ void done(const Unit&) const {}
};

__device__ __forceinline__ unsigned cvt_pk_bf16(float lo, float hi) { unsigned r; asm volatile("v_cvt_pk_bf16_f32 %0, %1, %2" : "=v"(r) : "v"(lo), "v"(hi)); return r; }
typedef float f32x2 __attribute__((ext_vector_type(2)));
#define EPI_ROW_RS(rs8, SSp, row0, fq) do { f32x4 p_[8]; \
        _Pragma("unroll") for (int i_ = 0; i_ < 8; ++i_) p_[i_] = *(const f32x4*)((SSp) + (size_t)((row0) + (i_ >> 2) * HALF + (i_ & 3) * 16) * 16 + 4 * (fq)); \
        asm volatile("" : "+v"(p_[0]), "+v"(p_[1]), "+v"(p_[2]), "+v"(p_[3]), "+v"(p_[4]), "+v"(p_[5]), "+v"(p_[6]), "+v"(p_[7])); \
        _Pragma("unroll") for (int i_ = 0; i_ < 8; ++i_) { float ssr = (p_[i_][0] + p_[i_][1]) + (p_[i_][2] + p_[i_][3]);       \
            { auto r = __builtin_amdgcn_permlane16_swap(__float_as_uint(ssr), __float_as_uint(ssr), false, false); ssr = __uint_as_float(r[0]) + __uint_as_float(r[1]); } \
            { auto r = __builtin_amdgcn_permlane32_swap(__float_as_uint(ssr), __float_as_uint(ssr), false, false); ssr = __uint_as_float(r[0]) + __uint_as_float(r[1]); } \
            float rsn = ssr + 1.024e-3f; asm volatile("" : "+v"(rsn)); rs8[i_] = __builtin_amdgcn_rsqf(rsn * (1.f / 1024.f)); } } while (0)
template <int ACT  > struct EpiStoreBf16 {
    static constexpr bool PERM = true, AFTER_DRAIN = false;
    bf16_t* O; int ldc; const float* SS;
    mutable float rs8[8]; mutable int cpm = -1;
    __device__ __forceinline__ void operator()(const f32x4 (&acc)[2][2][4][2], const Unit& u, int wr, int wc, int fr, int fq) const {
        const int row0 = u.pm * BM + wr * 64 + fr, col0 = u.pn * BM + wc * 32 + 8 * fq;
        if (u.pm != cpm) { EPI_ROW_RS(rs8, SS, row0, fq); cpm = u.pm; }
#pragma unroll
        for (int ai = 0; ai < 2; ++ai)
#pragma unroll
            for (int m = 0; m < 4; ++m) { bf16_t* rowp = O + (size_t)(row0 + ai * HALF + m * 16) * ldc + col0;
                const float rsn = rs8[ai * 4 + m];
#pragma unroll
                for (int bj = 0; bj < 2; ++bj) { f32x4 v0 = acc[ai][bj][m][0] * rsn, v1 = acc[ai][bj][m][1] * rsn;
                    if (ACT == 1) { const f32x4 z = {0.f, 0.f, 0.f, 0.f}; v0 = __builtin_elementwise_max(v0, z); v1 = __builtin_elementwise_max(v1, z); v0 = v0 * v0; v1 = v1 * v1; }
                    u32x4 w; w.x = cvt_pk_bf16(v0[0], v0[1]); w.y = cvt_pk_bf16(v0[2], v0[3]); w.z = cvt_pk_bf16(v1[0], v1[1]); w.w = cvt_pk_bf16(v1[2], v1[3]);
                    *(u32x4*)(rowp + bj * HALF) = w; } }
    }
};
struct EpiInProj {
    static constexpr bool PERM = true, AFTER_DRAIN = false;
    bf16_t* O; int ldc; const float* gq; const float* gk; const float* SS;
    mutable float rs8[8]; mutable int cpm = -1;
    __device__ __forceinline__ void operator()(const f32x4 (&acc)[2][2][4][2], const Unit& u, int wr, int wc, int fr, int fq) const {
        const int row0 = u.pm * BM + wr * 64 + fr, col0 = u.pn * BM + wc * 32 + 8 * fq;
        const bool nrm = u.pn < 2;
        f32x4 g0 = {1.f, 1.f, 1.f, 1.f}, g1 = g0;
        if (nrm) { const float* gs = (u.pn == 0 ? gq : gk) + 8 * fq; const float sc = (u.pn == 0) ? 0.17677669529663687f * 1.4426950408889634f : 1.f;
            g0 = *(const f32x4*)gs * sc; g1 = *(const f32x4*)(gs + 4) * sc; }
        if (u.pm != cpm) { EPI_ROW_RS(rs8, SS, row0, fq); cpm = u.pm; }
#pragma unroll
        for (int ai = 0; ai < 2; ++ai)
#pragma unroll
            for (int m = 0; m < 4; ++m) { bf16_t* rowp = O + (size_t)(row0 + ai * HALF + m * 16) * ldc + col0;
                const float rsn = rs8[ai * 4 + m];
#pragma unroll
                for (int bj = 0; bj < 2; ++bj) { f32x4 v0 = acc[ai][bj][m][0] * rsn, v1 = acc[ai][bj][m][1] * rsn;
                    if (nrm) { float ss = (v0[0] * v0[0] + v0[1] * v0[1]) + (v0[2] * v0[2] + v0[3] * v0[3]) + (v1[0] * v1[0] + v1[1] * v1[1]) + (v1[2] * v1[2] + v1[3] * v1[3]);
                        { auto r = __builtin_amdgcn_permlane16_swap(__float_as_uint(ss), __float_as_uint(ss), false, false); ss = __uint_as_float(r[0]) + __uint_as_float(r[1]); }
                        { auto r = __builtin_amdgcn_permlane32_swap(__float_as_uint(ss), __float_as_uint(ss), false, false); ss = __uint_as_float(r[0]) + __uint_as_float(r[1]); }
                        const float rs = RS_EPS(ss, 1.f / 32.f, 32e-6f);
                        v0 = v0 * rs * g0; v1 = v1 * rs * g1; }
                    u32x4 w; w.x = cvt_pk_bf16(v0[0], v0[1]); w.y = cvt_pk_bf16(v0[2], v0[3]); w.z = cvt_pk_bf16(v1[0], v1[1]); w.w = cvt_pk_bf16(v1[2], v1[3]);
                    *(u32x4*)(rowp + bj * HALF) = w; } }
    }
};
template <bool LAST> struct EpiResidB {
    static constexpr bool PERM = true, AFTER_DRAIN = false;
    bf16_t* XB; float* O; float* SS; int ldc;
    __device__ __forceinline__ void operator()(const f32x4 (&acc)[2][2][4][2], const Unit& u, int wr, int wc, int fr, int fq) const {
        const int row0 = u.pm * BM + wr * 64 + fr, col0 = u.pn * BM + wc * 32 + 8 * fq;
        u32x4 rbv[2][4][2];
#pragma unroll
        for (int ai = 0; ai < 2; ++ai)
#pragma unroll
            for (int m = 0; m < 4; ++m)
#pragma unroll
                for (int bj = 0; bj < 2; ++bj) rbv[ai][m][bj] = *(const u32x4*)(XB + (size_t)(row0 + ai * HALF + m * 16) * ldc + col0 + bj * HALF);
        asm volatile("" : "+v"(rbv[0][0][0]), "+v"(rbv[0][0][1]), "+v"(rbv[0][1][0]), "+v"(rbv[0][1][1]), "+v"(rbv[0][2][0]), "+v"(rbv[0][2][1]), "+v"(rbv[0][3][0]), "+v"(rbv[0][3][1]),
                         "+v"(rbv[1][0][0]), "+v"(rbv[1][0][1]), "+v"(rbv[1][1][0]), "+v"(rbv[1][1][1]), "+v"(rbv[1][2][0]), "+v"(rbv[1][2][1]), "+v"(rbv[1][3][0]), "+v"(rbv[1][3][1]));
#pragma unroll
        for (int ai = 0; ai < 2; ++ai)
#pragma unroll
            for (int m = 0; m < 4; ++m) { const int row = row0 + ai * HALF + m * 16; const size_t off = (size_t)row * ldc + col0; float ss = 0.f;
#pragma unroll
                for (int bj = 0; bj < 2; ++bj) { const u32x4 rb = rbv[ai][m][bj];
                    f32x4 x0, x1;
                    x0[0] = __builtin_bit_cast(float, rb.x << 16); x0[1] = __builtin_bit_cast(float, rb.x & 0xffff0000u); x0[2] = __builtin_bit_cast(float, rb.y << 16); x0[3] = __builtin_bit_cast(float, rb.y & 0xffff0000u);
                    x1[0] = __builtin_bit_cast(float, rb.z << 16); x1[1] = __builtin_bit_cast(float, rb.z & 0xffff0000u); x1[2] = __builtin_bit_cast(float, rb.w << 16); x1[3] = __builtin_bit_cast(float, rb.w & 0xffff0000u);
                    x0 = x0 + acc[ai][bj][m][0]; x1 = x1 + acc[ai][bj][m][1];
                    if (LAST) { *(f32x4*)(O + off + bj * HALF) = x0; *(f32x4*)(O + off + bj * HALF + 4) = x1; }
                    else { u32x4 w; w.x = cvt_pk_bf16(x0[0], x0[1]); w.y = cvt_pk_bf16(x0[2], x0[3]); w.z = cvt_pk_bf16(x1[0], x1[1]); w.w = cvt_pk_bf16(x1[2], x1[3]);
                        *(u32x4*)(XB + off + bj * HALF) = w;
                        ss += (x0[0] * x0[0] + x0[1] * x0[1]) + (x0[2] * x0[2] + x0[3] * x0[3]) + (x1[0] * x1[0] + x1[1] * x1[1]) + (x1[2] * x1[2] + x1[3] * x1[3]); } }
                if (!LAST) {
                    { auto r = __builtin_amdgcn_permlane16_swap(__float_as_uint(ss), __float_as_uint(ss), false, false); ss = __uint_as_float(r[0]) + __uint_as_float(r[1]); }
                    { auto r = __builtin_amdgcn_permlane32_swap(__float_as_uint(ss), __float_as_uint(ss), false, false); ss = __uint_as_float(r[0]) + __uint_as_float(r[1]); }
                    if (fq == 0) SS[(size_t)row * 16 + u.pn * 4 + wc] = ss; } }
    }
};
template <class Epi, class Sched, bool ALIGN_EPI = false, bool SP2 = false>
__device__ __forceinline__ void gemm_phase(PG8_LAS unsigned char* lds, const Gemm g, const Sched& S, const Epi& E, int wave0) {
    int tid_ = wave0 * 64 + LANE_ID(); asm volatile("" : "+v"(tid_));
    const int tid = tid_, wid = __builtin_amdgcn_readfirstlane(tid >> 6), lane = tid & 63, wr = wid >> 2, wc = wid & 3, fr = lane & 15, fq = lane >> 4;
    const int K = g.K, nt = K / BK;
    unsigned voffA[2], voffB[2];
#pragma unroll
    for (int i = 0; i < 2; ++i) { int R, C; stage_rc(tid * 16 + i * 8192, R, C); const int Rb = Epi::PERM ? ((R & ~31) + perm32(R & 31)) : R;
        voffA[i] = (unsigned)(R * g.lda + C) * 2u; voffB[i] = (unsigned)(Rb * K + C) * 2u; }
    const size_t kstep = (size_t)(BK * 2);
    const size_t hstep = (size_t)HALF * K * 2;
    const size_t tstep = 2 * hstep; const size_t hstepA = (size_t)HALF * g.lda * 2, tstepA = 2 * hstepA;
    const unsigned ldsw = (unsigned)wid * 1024u;
    const int aoff = lds_byte(wr * 64 + fr, fq * 8), boff = lds_byte(wc * 32 + fr, fq * 8);
#define PG8_SA(b, h) (((b) * 2 + (h)) * HTB)
#define PG8_SB(b, h) ((4 + (b) * 2 + (h)) * HTB)
#define PG8_STAGE(bufoff, gbase, voff) do { _Pragma("unroll") for (int _i = 0; _i < 2; ++_i) \
        __builtin_amdgcn_global_load_lds((const unsigned*)((const char*)(gbase) + (voff)[_i]), (PG8_LAS unsigned*)(lds + (bufoff) + ldsw + _i * 8192), 16, 0, 0); } while (0)
#define PG8_LDA(dst, b, h) do { _Pragma("unroll") for (int m = 0; m < 4; ++m) _Pragma("unroll") for (int k = 0; k < 2; ++k) dst[m][k] = *(const PG8_LAS bf16x8*)(lds + PG8_SA(b, h) + aoff + m * 2048 + k * 1024); } while (0)
#define PG8_LDB(dst, b, h) do { _Pragma("unroll") for (int n = 0; n < 2; ++n) _Pragma("unroll") for (int k = 0; k < 2; ++k) dst[n][k] = *(const PG8_LAS bf16x8*)(lds + PG8_SB(b, h) + boff + n * 2048 + k * 1024); } while (0)
#define PG8_MMA(ai, bj, At, Bt) do { __builtin_amdgcn_s_setprio(1); _Pragma("unroll") for (int m = 0; m < 4; ++m) _Pragma("unroll") for (int n = 0; n < 2; ++n) _Pragma("unroll") for (int k = 0; k < 2; ++k) \
        acc[ai][bj][m][n] = __builtin_amdgcn_mfma_f32_16x16x32_bf16(Bt[n][k], At[m][k], acc[ai][bj][m][n], 0, 0, 0); __builtin_amdgcn_s_setprio(0); } while (0)
#define PG8_WAIT_V(n) asm volatile("s_waitcnt vmcnt(" #n ")" ::: "memory")
#define PG8_WAIT_L(n) asm volatile("s_waitcnt lgkmcnt(" #n ")" ::: "memory")
#define PG8_BAR __builtin_amdgcn_s_barrier()
#define PG8_SCHED __builtin_amdgcn_sched_barrier(0)
    Unit cur, nxt; int ui = 0;
    if (!S.next(0, cur)) return;
    f32x4 acc[2][2][4][2];
#pragma unroll
    for (int a = 0; a < 2; ++a)
#pragma unroll
        for (int b = 0; b < 2; ++b)
#pragma unroll
            for (int m = 0; m < 4; ++m)
#pragma unroll
                for (int n = 0; n < 2; ++n) acc[a][b][m][n] = (f32x4){0.f, 0.f, 0.f, 0.f};
    bf16x8 At[4][2], B0[2][2], B1[2][2];
    const char* cA = (const char*)g.A + (size_t)cur.pm * tstepA; const char* cB = (const char*)g.Bt + (size_t)cur.pn * tstep;
    S.a_ready(cur);
    if constexpr (SP2) {
        PG8_STAGE(PG8_SB(0, 0), cB, voffB); PG8_STAGE(PG8_SB(0, 1), cB + hstep, voffB); PG8_STAGE(PG8_SA(0, 0), cA, voffA); PG8_STAGE(PG8_SA(0, 1), cA + hstepA, voffA);
        if (wr == 1) PG8_BAR;
        PG8_WAIT_V(2); PG8_BAR;
        PG8_STAGE(PG8_SB(1, 0), cB + kstep, voffB); PG8_STAGE(PG8_SA(1, 0), cA + kstep, voffA); PG8_STAGE(PG8_SB(1, 1), cB + hstep + kstep, voffB);
        PG8_WAIT_V(6); PG8_BAR;
    } else {
        PG8_STAGE(PG8_SB(0, 0), cB, voffB); PG8_STAGE(PG8_SA(0, 0), cA, voffA); PG8_STAGE(PG8_SB(0, 1), cB + hstep, voffB); PG8_STAGE(PG8_SA(0, 1), cA + hstepA, voffA);
        if (wr == 1) PG8_BAR;
        PG8_WAIT_V(4); PG8_BAR;
        PG8_STAGE(PG8_SB(1, 0), cB + kstep, voffB); PG8_STAGE(PG8_SA(1, 0), cA + kstep, voffA); PG8_STAGE(PG8_SB(1, 1), cB + hstep + kstep, voffB);
        PG8_WAIT_V(6); PG8_BAR;
    }
    for (;;) {
        const bool has_next = S.next(ui + 1, nxt);
        const char* nA = has_next ? (const char*)g.A + (size_t)nxt.pm * tstepA : cA; const char* nB = has_next ? (const char*)g.Bt + (size_t)nxt.pn * tstep : cB;
        for (int t = 0; t < nt; t += 2) {
            const bool last = (t == nt - 2);
            const char* a1 = cA + (size_t)(t + 1) * kstep;
            const char* a2 = last ? nA : cA + (size_t)(t + 2) * kstep; const char* b2 = last ? nB : cB + (size_t)(t + 2) * kstep;
            const char* a3 = a2 + kstep; const char* b3 = b2 + kstep;
            if (last && has_next) S.a_ready(nxt);
            if constexpr (SP2) {
            PG8_LDB(B0, 0, 0); PG8_LDB(B1, 0, 1); PG8_SCHED; PG8_LDA(At, 0, 0); PG8_STAGE(PG8_SA(1, 1), a1 + hstepA, voffA);
            PG8_WAIT_V(8); PG8_WAIT_L(0); PG8_BAR; PG8_MMA(0, 0, At, B0); PG8_MMA(0, 1, At, B1); PG8_BAR; PG8_SCHED;
            PG8_LDA(At, 0, 1); PG8_STAGE(PG8_SB(0, 0), b2, voffB); PG8_STAGE(PG8_SB(0, 1), b2 + hstep, voffB); PG8_STAGE(PG8_SA(0, 0), a2, voffA);
            PG8_WAIT_V(8); PG8_WAIT_L(0); PG8_BAR; PG8_MMA(1, 0, At, B0); PG8_MMA(1, 1, At, B1); PG8_BAR; PG8_SCHED;
            PG8_LDB(B0, 1, 0); PG8_LDB(B1, 1, 1); PG8_SCHED; PG8_LDA(At, 1, 0); PG8_STAGE(PG8_SA(0, 1), a2 + hstepA, voffA);
            PG8_WAIT_V(8); PG8_WAIT_L(0); PG8_BAR; PG8_MMA(0, 0, At, B0); PG8_MMA(0, 1, At, B1); PG8_BAR; PG8_SCHED;
            PG8_LDA(At, 1, 1); PG8_STAGE(PG8_SB(1, 0), b3, voffB); PG8_STAGE(PG8_SB(1, 1), b3 + hstep, voffB); PG8_STAGE(PG8_SA(1, 0), a3, voffA);
            PG8_WAIT_V(8); PG8_WAIT_L(0); PG8_BAR; PG8_MMA(1, 0, At, B0); PG8_MMA(1, 1, At, B1); PG8_BAR; PG8_SCHED;
            } else {
            PG8_LDB(B0, 0, 0); PG8_SCHED; PG8_LDA(At, 0, 0); PG8_STAGE(PG8_SA(1, 1), a1 + hstepA, voffA);
            PG8_WAIT_L(8); PG8_BAR; PG8_WAIT_L(0); PG8_MMA(0, 0, At, B0); PG8_BAR; PG8_SCHED;
            PG8_LDB(B1, 0, 1); PG8_STAGE(PG8_SB(0, 0), b2, voffB);
            PG8_BAR; PG8_WAIT_L(0); PG8_MMA(0, 1, At, B1); PG8_BAR;
            PG8_LDA(At, 0, 1); PG8_STAGE(PG8_SA(0, 0), a2, voffA);
            PG8_BAR; PG8_WAIT_L(0); PG8_MMA(1, 0, At, B0); PG8_BAR; PG8_SCHED;
            PG8_STAGE(PG8_SB(0, 1), b2 + hstep, voffB);
            PG8_WAIT_V(6); PG8_BAR; PG8_MMA(1, 1, At, B1); PG8_BAR;
            PG8_LDB(B0, 1, 0); PG8_SCHED; PG8_LDA(At, 1, 0); PG8_STAGE(PG8_SA(0, 1), a2 + hstepA, voffA);
            PG8_WAIT_L(8); PG8_BAR; PG8_WAIT_L(0); PG8_MMA(0, 0, At, B0); PG8_BAR; PG8_SCHED;
            PG8_LDB(B1, 1, 1); PG8_STAGE(PG8_SB(1, 0), b3, voffB);
            PG8_BAR; PG8_WAIT_L(0); PG8_MMA(0, 1, At, B1); PG8_BAR;
            PG8_LDA(At, 1, 1); PG8_STAGE(PG8_SA(1, 0), a3, voffA);
            PG8_BAR; PG8_WAIT_L(0); PG8_MMA(1, 0, At, B0); PG8_BAR; PG8_SCHED;
            PG8_STAGE(PG8_SB(1, 1), b3 + hstep, voffB);
            PG8_WAIT_V(6); PG8_BAR; PG8_MMA(1, 1, At, B1); PG8_BAR;
            }
        }
        if constexpr (ALIGN_EPI) { if (wr == 0) PG8_BAR; }
        if constexpr (!Epi::AFTER_DRAIN) { E(acc, cur, wr, wc, fr, fq); S.done(cur); }
        if (!has_next) break;
#pragma unroll
        for (int a = 0; a < 2; ++a)
#pragma unroll
            for (int b = 0; b < 2; ++b)
#pragma unroll
                for (int m = 0; m < 4; ++m)
#pragma unroll
                    for (int n = 0; n < 2; ++n) acc[a][b][m][n] = (f32x4){0.f, 0.f, 0.f, 0.f};
        cur = nxt; cA = nA; cB = nB; ++ui;
        if constexpr (ALIGN_EPI) { if (wr == 1) PG8_BAR; }
    }
    PG8_WAIT_V(0);
    if constexpr (!ALIGN_EPI) { if (wr == 0) PG8_BAR; }
    PG8_BAR;
    if constexpr (Epi::AFTER_DRAIN) { E.fused(acc, cur, wr, wc, fr, fq, lds, wid, lane); S.done(cur); }
#undef PG8_SA
#undef PG8_SB
#undef PG8_STAGE
#undef PG8_LDA
#undef PG8_LDB
#undef PG8_MMA
#undef PG8_WAIT_V
#undef PG8_WAIT_L
#undef PG8_BAR
#undef PG8_SCHED
}
}
typedef unsigned u32x4 __attribute__((ext_vector_type(4)));
#define GAS __attribute__((address_space(1)))
#define LAS __attribute__((address_space(3)))
typedef unsigned short bf16;
typedef unsigned v4u __attribute__((ext_vector_type(4)));
typedef unsigned u32x2 __attribute__((ext_vector_type(2)));
typedef float f32x4 __attribute__((ext_vector_type(4)));
typedef short bf16x8 __attribute__((ext_vector_type(8)));
typedef GAS unsigned gu32;
typedef GAS unsigned long long gu64;
#define RLX_AGENT __ATOMIC_RELAXED, __HIP_MEMORY_SCOPE_AGENT
#define LDS_WAIT() asm volatile("s_waitcnt lgkmcnt(0)" ::: "memory")
#define VM_WAIT() asm volatile("s_waitcnt vmcnt(0)" ::: "memory")
__device__ __forceinline__ unsigned long long rt() { return __builtin_amdgcn_s_memrealtime(); }
__device__ __forceinline__ unsigned f2bf(float f) { return (unsigned)__builtin_bit_cast(unsigned short, (__bf16)f); }
typedef float f32x2_c __attribute__((ext_vector_type(2))); typedef __bf16 bf16x2_c __attribute__((ext_vector_type(2)));
__device__ __forceinline__ unsigned pk2(float lo, float hi) { const f32x2_c v = {lo, hi}; return __builtin_bit_cast(unsigned, __builtin_convertvector(v, bf16x2_c)); }

#define XB_TMO      128
#define XB_XCNT(j)  (256  + 64 * (j))
#define XB_XSUB(j)  (1280 + 64 * (j))
#define XB_XGEN(j)  (2304 + 64 * (j))
#define XB_TOP      3328
#define XB_TOPGEN   3392
#define XCD_BAR_WORDS 3456
#define XB_SPIN_CAP (1u << 20)

__device__ __forceinline__ unsigned xb_ld(unsigned* p)              { return __hip_atomic_load(p, __ATOMIC_RELAXED, __HIP_MEMORY_SCOPE_AGENT); }
__device__ __forceinline__ unsigned xb_add(unsigned* p, unsigned v) { return __hip_atomic_fetch_add(p, v, __ATOMIC_RELAXED, __HIP_MEMORY_SCOPE_AGENT); }
__device__ __forceinline__ unsigned xb_xcc_id() { return (unsigned)__builtin_amdgcn_s_getreg((3 << 11) | 20) & 0xFu; }
#define XB_SPIN(cond, bar) do { unsigned _sp = 0; while (cond) { __builtin_amdgcn_s_sleep(1); \
    if ((++_sp & 255u) == 0u) { if (xb_ld(&(bar)[XB_TMO])) break; if (_sp > XB_SPIN_CAP) { atomicAdd(&(bar)[XB_TMO], 1u); break; } } } } while (0)

struct XcdBarrier {
    unsigned* bar; unsigned x; int wv;
    volatile LAS unsigned* st;
};

__device__ __forceinline__ XcdBarrier xcd_barrier_post(unsigned* bar, volatile LAS unsigned* st) {
    XcdBarrier b; b.bar = bar; b.x = (unsigned)__builtin_amdgcn_readfirstlane((int)xb_xcc_id()); b.st = st;
    if (threadIdx.x == 0) (void)xb_add(&bar[XB_XCNT(b.x)], 1u);
    return b;
}
__device__ __forceinline__ void xcd_barrier_complete(unsigned* bar, unsigned x, unsigned& nloc, unsigned& nx) {
    const unsigned G = gridDim.x * gridDim.y * gridDim.z;
    unsigned sum, cnt, mine, sp = 0u;
    for (;;) {
        sum = 0u; cnt = 0u; mine = 0u;
#pragma unroll
        for (unsigned j = 0; j < 16; ++j) { const unsigned c = xb_ld(&bar[XB_XCNT(j)]); sum += c; cnt += (c > 0u) ? 1u : 0u; mine = (j == x) ? c : mine; }
        if (sum == G) break;
        __builtin_amdgcn_s_sleep(1);
        if ((++sp & 255u) == 0u) { if (xb_ld(&bar[XB_TMO])) break; if (sp > XB_SPIN_CAP) { atomicAdd(&bar[XB_TMO], 1u); break; } }
    }
    nloc = mine > 0u ? mine : 1u; nx = cnt > 0u ? cnt : 1u;
}

__device__ __forceinline__ void xcd_barrier(const XcdBarrier& b) {
    asm volatile("s_waitcnt vmcnt(0)" ::: "memory");
    __syncthreads();
    if (b.wv == 0 && LANE_ID() == 0) {
        unsigned* bar = b.bar;
        __builtin_amdgcn_s_waitcnt(0);
        unsigned nloc = b.st[0], nx = b.st[1];
        if (nloc == 0u) { xcd_barrier_complete(bar, b.x, nloc, nx); b.st[0] = nloc; b.st[1] = nx; }
        const unsigned old = xb_add(&bar[XB_XSUB(b.x)], 1u);
        const unsigned gen = old / nloc;
        if (old + 1u == (gen + 1u) * nloc) {
            __builtin_amdgcn_fence(__ATOMIC_RELEASE, "agent");
            asm volatile("s_waitcnt vmcnt(0)" ::: "memory");
            const unsigned og = xb_add(&bar[XB_TOP], 1u);
            const unsigned tg = og / nx;
            if (og + 1u == (tg + 1u) * nx) xb_add(&bar[XB_TOPGEN], 1u);
            else XB_SPIN(xb_ld(&bar[XB_TOPGEN]) == tg, bar);
            __builtin_amdgcn_fence(__ATOMIC_ACQUIRE, "agent");
            xb_add(&bar[XB_XGEN(b.x)], 1u);
            asm volatile("s_waitcnt vmcnt(0)" ::: "memory");
        } else {
            XB_SPIN(xb_ld(&bar[XB_XGEN(b.x)]) == gen, bar);
            __builtin_amdgcn_fence(__ATOMIC_ACQUIRE, "agent");
            asm volatile("s_waitcnt vmcnt(0)" ::: "memory");
        }
    }
    __syncthreads();
}
__device__ __forceinline__ void xcd_split_arrive(const XcdBarrier& b, unsigned* sb, unsigned round) {
    asm volatile("s_waitcnt vmcnt(0)" ::: "memory");
    __syncthreads();
    if (b.wv == 0 && LANE_ID() == 0) {
        __builtin_amdgcn_s_waitcnt(0);
        const unsigned nloc = b.st[0], nx = b.st[1];
        const unsigned old = xb_add(&sb[XB_XSUB(b.x)], 1u);
        if (old + 1u == (round + 1u) * nloc) {
            __builtin_amdgcn_fence(__ATOMIC_RELEASE, "agent");
            asm volatile("s_waitcnt vmcnt(0)" ::: "memory");
            const unsigned og = xb_add(&sb[XB_TOP], 1u);
            if (og + 1u == (round + 1u) * nx) xb_add(&sb[XB_TOPGEN], 1u);
        }
    }
}
__device__ __forceinline__ void xcd_split_wait(const XcdBarrier& b, unsigned* sb, unsigned round) {
    if (b.wv == 0 && LANE_ID() == 0) {
        XB_SPIN(xb_ld(&sb[XB_TOPGEN]) <= round, b.bar);
        __builtin_amdgcn_fence(__ATOMIC_ACQUIRE, "agent");
        asm volatile("s_waitcnt vmcnt(0)" ::: "memory");
    }
    __syncthreads();
}
constexpr int NWAVES = 8;
constexpr int BATCH = 8, SEQ = 8192, D = 1024, M = BATCH * SEQ, NL = 4, PIN = 3472, PINP = 3584, FF = 4096;
constexpr int SA0 = 0, SB0 = 768, SC0 = 1552, SD0 = 2576;
constexpr float LOG2E = 1.4426950408889634f;
constexpr size_t MiB = 1u << 20;
constexpr size_t WS_CTL = 0, CTL_ZERO_BYTES = 65536;
constexpr size_t WS_LC = 1 * MiB;
constexpr size_t WS_LB = 1 * MiB + 65536;
constexpr size_t WS_BS = 2 * MiB;
constexpr size_t WS_ZG = 4 * MiB;
constexpr size_t WS_WI = 20 * MiB, WS_WO = 48 * MiB, WS_WU = 56 * MiB, WS_WD = 88 * MiB;
constexpr size_t WS_PR = 120 * MiB;
constexpr size_t WS_SC = 568 * MiB;
constexpr size_t WS_X2 = 856 * MiB;
constexpr size_t WS_H = 120 * MiB;
constexpr size_t WS_SS = 984 * MiB;
constexpr size_t WS_END = 1020 * MiB;
constexpr size_t SC_RWS = 0, SC_HS = 160 * MiB, SC_GS = 224 * MiB;
constexpr int CW_TMO = 0, CW_CODE = 1, CW_BAR = 4096, CW_SBAR = 8192;
constexpr int RING_OFF = 0, RING_BYTES = 131072;
constexpr int LDSCTL_OFF = RING_BYTES, MISC_OFF = LDSCTL_OFF + 320;
constexpr int LDS_BYTES = 147456;
typedef float f32x16 __attribute__((ext_vector_type(16)));
typedef short s16x4 __attribute__((ext_vector_type(4)));
struct Args { const float* in[30]; float* out; unsigned char* ws; };
struct Frame {
    LAS unsigned char* lds;
    volatile LAS unsigned* MISC;
    gu32* ctl;
    int tid, lane, wave;
    int vcu, G;
    float* out; unsigned char* ws;
};
#define LDS_BAR() asm volatile("s_waitcnt lgkmcnt(0)\n\ts_barrier" ::: "memory")
__device__ __forceinline__ int lane_id() { return LANE_ID(); }
__device__ __forceinline__ int crow32(int r, int hi) { return (r & 3) + 8 * (r >> 2) + 4 * hi; }
__device__ __forceinline__ float bf2f(unsigned short b) { return __builtin_bit_cast(float, (unsigned)b << 16); }
template <int CTRL> __device__ __forceinline__ float dppf(float v) { return __builtin_bit_cast(float, __builtin_amdgcn_update_dpp(0, __builtin_bit_cast(int, v), CTRL, 0xf, 0xf, true)); }
__device__ __forceinline__ float wave_sum(float v) {
    v += dppf<0xB1>(v); v += dppf<0x4E>(v); v += dppf<0x141>(v); v += dppf<0x140>(v);
    { auto r = __builtin_amdgcn_permlane16_swap(__float_as_uint(v), __float_as_uint(v), false, false); v = __uint_as_float(r[0]) + __uint_as_float(r[1]); }
    { auto r = __builtin_amdgcn_permlane32_swap(__float_as_uint(v), __float_as_uint(v), false, false); v = __uint_as_float(r[0]) + __uint_as_float(r[1]); }
    return v;
}
__device__ __forceinline__ float wave_max(float v) {
#pragma unroll
    for (int o = 1; o < 64; o <<= 1) v = fmaxf(v, __shfl_xor(v, o));
    return v;
}
__device__ __forceinline__ float sigmoidf_(float x) { return __builtin_amdgcn_rcpf(1.f + __expf(-x)); }

__device__ __forceinline__ void p0_transpose_item(const float* W, int K, int N, int NP, bf16* WT, LAS float* scr, int item, int lane, const float* gain = nullptr) {
    const int nblk = NP / 32, kb = item / nblk, nb = item % nblk, k0 = 64 * kb, n0 = 32 * nb;
    const int ncol = n0 + (lane & 31);
#pragma unroll 8
    for (int i = 0; i < 32; ++i) { const int kk = 2 * i + (lane >> 5); scr[kk * 33 + (lane & 31)] = (ncol < N) ? W[(size_t)(k0 + kk) * N + ncol] * (gain ? gain[k0 + kk] : 1.f) : 0.f; }
    LDS_WAIT(); asm volatile("" ::: "memory");
    const int c = lane & 7;
#pragma unroll
    for (int j = 0; j < 4; ++j) { const int n = (lane >> 3) + 8 * j; const LAS float* s = scr + (8 * c) * 33 + n;
        v4u o; o.x = pk2(s[0 * 33], s[1 * 33]); o.y = pk2(s[2 * 33], s[3 * 33]); o.z = pk2(s[4 * 33], s[5 * 33]); o.w = pk2(s[6 * 33], s[7 * 33]);
        *(GAS v4u*)(WT + (size_t)(n0 + n) * K + k0 + 8 * c) = o; }
    LDS_WAIT(); asm volatile("" ::: "memory");
}
__device__ __forceinline__ void p0_prologue(Frame& F, const Args& A) {
    LAS float* scr = (LAS float*)(F.lds + RING_OFF + F.wave * 16384);
    const int gw = F.vcu * NWAVES + F.wave, NGW = F.G * NWAVES;
    constexpr int I_I = (D / 64) * (PINP / 32), I_O = (D / 64) * (D / 32), I_U = (D / 64) * (FF / 32), I_D = (FF / 64) * (D / 32);
    constexpr int PER_L = I_I + I_O + I_U + I_D;
    for (int it = gw; it < NL * PER_L; it += NGW) {
        const int l = it / PER_L; int r = it % PER_L;
        if (r < I_I) { p0_transpose_item(A.in[2] + (size_t)l * D * PIN, D, PIN, PINP, (bf16*)(F.ws + WS_WI) + (size_t)l * PINP * D, scr, r, F.lane, A.in[1] + l * D); continue; } r -= I_I;
        if (r < I_O) { p0_transpose_item(A.in[26] + (size_t)l * D * D, D, D, D, (bf16*)(F.ws + WS_WO) + (size_t)l * D * D, scr, r, F.lane); continue; } r -= I_O;
        if (r < I_U) { p0_transpose_item(A.in[28] + (size_t)l * D * FF, D, FF, FF, (bf16*)(F.ws + WS_WU) + (size_t)l * FF * D, scr, r, F.lane, A.in[27] + l * D); continue; } r -= I_U;
        p0_transpose_item(A.in[29] + (size_t)l * FF * D, FF, D, D, (bf16*)(F.ws + WS_WD) + (size_t)l * D * FF, scr, r, F.lane);
    }
    if (blockIdx.x == 0 && F.wave == 0) {
        for (int l = 0; l < NL; ++l) {
            const int i = F.lane & 31; const bool on = F.lane < 32;
            const float s1 = wave_sum(on ? A.in[5][l * 32 + i] * A.in[6][l * 32 + i] : 0.f);
            const float s2 = wave_sum(on ? A.in[7][l * 32 + i] * A.in[8][l * 32 + i] : 0.f);
            const float gq = wave_max(fabsf(A.in[3][l * 32 + i])), gk = wave_max(fabsf(A.in[4][l * 32 + i]));
            const float lam_init = 0.8f - 0.6f * expf(-0.3f * (float)l);
            if (F.lane == 0) { ((float*)(F.ws + WS_LC))[l * 16 + 0] = expf(s1) - expf(s2) + lam_init; ((float*)(F.ws + WS_LC))[l * 16 + 1] = lam_init; ((float*)(F.ws + WS_LC))[l * 16 + 2] = LOG2E * 5.656854249f * gq * gk; }
        }
    }
    if (blockIdx.x == 0 && F.wave >= 1 && F.wave <= 4) {
        const int c = (F.wave - 1) * 64 + F.lane;
        float z[NL], mx = -1e30f, sum = 0.f;
        for (int l = 0; l < NL; ++l) { z[l] = A.in[13][l * 256 + c]; mx = fmaxf(mx, z[l]); }
        for (int l = 0; l < NL; ++l) { z[l] = expf(z[l] - mx); sum += z[l]; }
        float cum = 0.f;
        for (int l = 0; l < NL; ++l) { if (l > 0) cum += z[l] / sum; ((float*)(F.ws + WS_LB))[l * 256 + c] = cum; }
    }
}
__device__ __forceinline__ void x0_phase(Frame& F, const float* src, bf16* dst, float* ss) {
    const int gw = F.vcu * NWAVES + F.wave, NGW = F.G * NWAVES;
    for (int m = gw; m < M; m += NGW) {
        const GAS f32x4* xr = (const GAS f32x4*)(src + (size_t)m * D) + F.lane;
        f32x4 v[4]; float s = 0.f;
#pragma unroll
        for (int j = 0; j < 4; ++j) { v[j] = xr[64 * j]; s += (v[j].x * v[j].x + v[j].y * v[j].y) + (v[j].z * v[j].z + v[j].w * v[j].w); }
        s = wave_sum(s);
        GAS unsigned long long* o8 = (GAS unsigned long long*)(dst + (size_t)m * D) + F.lane;
#pragma unroll
        for (int j = 0; j < 4; ++j) o8[64 * j] = (unsigned long long)pk2(v[j].x, v[j].y) | ((unsigned long long)pk2(v[j].z, v[j].w) << 32);
        if (F.lane < 16) ss[(size_t)m * 16 + F.lane] = (F.lane == 0) ? s : 0.f;
    }
}
__device__ __forceinline__ void prep_attn(Frame& F, const Args& A, int l) {
    const int gw = F.vcu * NWAVES + F.wave, NGW = F.G * NWAVES;
    float g8[8];
    { const float* gsrc = (F.lane < 32 ? A.in[3] : A.in[4]) + l * 32 + (F.lane & 3) * 8; const float sc = F.lane < 32 ? 0.17677669529663687f * LOG2E : 1.f;
#pragma unroll
      for (int i = 0; i < 8; ++i) g8[i] = gsrc[i] * sc; }
    for (int m0 = gw; m0 < M; m0 += 4 * NGW) {
        v4u raw4[4];
#pragma unroll
        for (int u = 0; u < 4; ++u) raw4[u] = (m0 + u * NGW < M) ? *((GAS v4u*)(((bf16*)(F.ws + WS_PR)) + (size_t)(m0 + u * NGW) * PINP + SA0) + F.lane) : (v4u){0u, 0u, 0u, 0u};
#pragma unroll
        for (int u = 0; u < 4; ++u) {
            const v4u raw = raw4[u]; float v[8];
#pragma unroll
            for (int i = 0; i < 4; ++i) { v[2 * i] = __builtin_bit_cast(float, raw[i] << 16); v[2 * i + 1] = __builtin_bit_cast(float, raw[i] & 0xffff0000u); }
            float s = 0.f;
#pragma unroll
            for (int i = 0; i < 8; ++i) s += v[i] * v[i];
            s += dppf<0xB1>(s); s += dppf<0x4E>(s);
            const float rs = rsqrtf(s * (1.f / 32.f) + 1e-6f);
            v4u o;
#pragma unroll
            for (int i = 0; i < 4; ++i) o[i] = pk2(v[2 * i] * rs * g8[2 * i], v[2 * i + 1] * rs * g8[2 * i + 1]);
            if (m0 + u * NGW < M) *((GAS v4u*)(((bf16*)(F.ws + WS_PR)) + (size_t)(m0 + u * NGW) * PINP + SA0) + F.lane) = o;
        }
    }
}
__device__ __forceinline__ void prep_scalars(Frame& F, const Args& A, int l) {
    LAS unsigned char* lrb = F.lds + RING_OFF;
    LAS unsigned char* gdb = F.lds + RING_OFF + 4608;
    LAS float* xwl = (LAS float*)(F.lds + RING_OFF + 8192);
    LAS float* xal = xwl + 32 * 256;
    LAS float* gxl = xal + 32 * 256;
    bf16* RWS = (bf16*)(F.ws + WS_SC + SC_RWS); bf16* HS = (bf16*)(F.ws + WS_SC + SC_HS); bf16* GS = (bf16*)(F.ws + WS_SC + SC_GS);
    const int tid = F.tid, c = tid & 255, th = __builtin_amdgcn_readfirstlane(tid >> 8), h = __builtin_amdgcn_readfirstlane(c >> 6), lane = F.lane;
    const float* mu = A.in[15] + l * 896;
    const float mu_r = mu[c], mu_k = mu[256 + c], w0c = A.in[16][l * 256 + c], a0c = A.in[18][l * 256 + c], kkc = A.in[21][l * 256 + c], kac = A.in[22][l * 256 + c], rkc = A.in[23][l * 256 + c];
    const float lbc = ((float*)(F.ws + WS_LB))[l * 256 + c];
    const int r32 = lane & 31, hi = lane >> 5, wv = F.wave;
    bf16x8 bw[2], ba[2], bg;
#pragma unroll
    for (int kk = 0; kk < 2; ++kk)
#pragma unroll
        for (int i = 0; i < 8; ++i) { const int j = 16 * kk + 8 * hi + i; bw[kk][i] = (short)f2bf(A.in[17][(l * 32 + j) * 256 + 32 * wv + r32]); ba[kk][i] = (short)f2bf(A.in[19][(l * 32 + j) * 256 + 32 * wv + r32]); }
#pragma unroll
    for (int i = 0; i < 8; ++i) bg[i] = (short)f2bf(A.in[10][(l * 16 + 8 * hi + i) * 128 + 32 * (wv & 3) + r32]);
    const int c2 = tid & 127, tq = __builtin_amdgcn_readfirstlane(tid >> 7), h2 = c2 >> 5;
    const float gb = A.in[11][l * 128 + c2];
    const int c4 = 4 * lane, hl = lane >> 4, cw = c4 & 63, c4g = 4 * (lane & 31), tsub = lane >> 5, h2g = c4g >> 5;
    const f32x4 mur4 = *(const f32x4*)(mu + c4), muk4 = *(const f32x4*)(mu + 256 + c4), w04 = *(const f32x4*)(A.in[16] + l * 256 + c4), a04 = *(const f32x4*)(A.in[18] + l * 256 + c4),
                kkc4 = *(const f32x4*)(A.in[21] + l * 256 + c4), kac4 = *(const f32x4*)(A.in[22] + l * 256 + c4), rkc4 = *(const f32x4*)(A.in[23] + l * 256 + c4),
                lb4 = *(const f32x4*)((float*)(F.ws + WS_LB) + l * 256 + c4), gb4 = *(const f32x4*)(A.in[11] + l * 128 + c4g);
    bf16 s1r[4], s1p[4], s1g;
    u32x2 i_rr[4], i_kr[4], i_rp[4], i_kp[4], i_hq[4], i_hz[4], i_gq[2], i_gk[2];
#define PS_HEAD(M0) do { const int m0_ = (M0), t0_ = m0_ % SEQ; \
        _Pragma("unroll") for (int e = 0; e < 4; ++e) { const int idx = tid * 4 + e, i = idx >> 6, j = idx & 63; const size_t m = (size_t)m0_ + i; \
            s1r[e] = ((bf16*)(F.ws + WS_PR))[m * PINP + SD0 + 768 + j]; s1p[e] = ((bf16*)(F.ws + WS_PR))[(m - (t0_ + i > 0 ? 1 : 0)) * PINP + SD0 + 768 + j]; } \
        s1g = ((bf16*)(F.ws + WS_PR))[((size_t)m0_ + (tid >> 4)) * PINP + SB0 + 512 + (tid & 15)]; } while (0)
#define PS_LOADT(k, M0) do { const int tok_ = 4 * wv + (k), t_ = (M0) % SEQ + tok_; const bf16* row = ((bf16*)(F.ws + WS_PR)) + ((size_t)(M0) + tok_) * PINP + c4; const bf16* rowp = row - (t_ > 0 ? PINP : 0); \
        i_rr[k] = *(const u32x2*)(row + SD0); i_kr[k] = *(const u32x2*)(row + SD0 + 256); i_rp[k] = *(const u32x2*)(rowp + SD0); i_kp[k] = *(const u32x2*)(rowp + SD0 + 256); \
        i_hq[k] = *(const u32x2*)(row + SC0); i_hz[k] = *(const u32x2*)(row + SC0 + 256); } while (0)
#define PG_LOADT(q, M0) do { const bf16* row = ((bf16*)(F.ws + WS_PR)) + ((size_t)(M0) + 4 * wv + 2 * (q) + tsub) * PINP + SB0 + c4g; i_gq[q] = *(const u32x2*)row; i_gk[q] = *(const u32x2*)(row + 128); } while (0)
#define BF4(v, o) do { o[0] = __builtin_bit_cast(float, (v).x << 16); o[1] = __builtin_bit_cast(float, (v).x & 0xffff0000u); o[2] = __builtin_bit_cast(float, (v).y << 16); o[3] = __builtin_bit_cast(float, (v).y & 0xffff0000u); } while (0)
#define ROW16(v) do { v += dppf<0xB1>(v); v += dppf<0x4E>(v); v += dppf<0x141>(v); v += dppf<0x140>(v); } while (0)
    if (F.vcu < M / 32) { PS_HEAD(F.vcu * 32);
#pragma unroll
        for (int k = 0; k < 4; ++k) PS_LOADT(k, F.vcu * 32);
        PG_LOADT(0, F.vcu * 32); PG_LOADT(1, F.vcu * 32); }
    for (int u = F.vcu; u < M / 32; u += F.G) {
        const int m0 = u * 32, bl = m0 / SEQ, t0 = m0 % SEQ;
#pragma unroll
        for (int e = 0; e < 4; ++e) { const int idx = tid * 4 + e, i = idx >> 6, j = idx & 63;
            const float raw = bf2f(s1r[e]); const float prev = (t0 + i > 0) ? bf2f(s1p[e]) : 0.f;
            float val = raw + mu[768 + j] * (prev - raw); if (j < 32) val = tanhf(val); *(LAS bf16*)(lrb + i * 144 + j * 2) = (bf16)f2bf(val); }
        { const int i = tid >> 4, j = tid & 15; *(LAS bf16*)(gdb + i * 48 + j * 2) = s1g; }
        LDS_BAR();
        {
            f32x16 cw_ = {}, ca = {};
#pragma unroll
            for (int kk = 0; kk < 2; ++kk) {
                const bf16x8 aw = *(const LAS bf16x8*)(lrb + r32 * 144 + (16 * kk + 8 * hi) * 2), aa = *(const LAS bf16x8*)(lrb + r32 * 144 + (32 + 16 * kk + 8 * hi) * 2);
                cw_ = __builtin_amdgcn_mfma_f32_32x32x16_bf16(aw, bw[kk], cw_, 0, 0, 0); ca = __builtin_amdgcn_mfma_f32_32x32x16_bf16(aa, ba[kk], ca, 0, 0, 0); }
#pragma unroll
            for (int r = 0; r < 16; ++r) { const int tok = crow32(r, hi); xwl[tok * 256 + 32 * wv + r32] = cw_[r]; xal[tok * 256 + 32 * wv + r32] = ca[r]; }
            if (wv < 4) { f32x16 cg = {}; const bf16x8 ag = *(const LAS bf16x8*)(gdb + r32 * 48 + 8 * hi * 2);
                cg = __builtin_amdgcn_mfma_f32_32x32x16_bf16(ag, bg, cg, 0, 0, 0);
#pragma unroll
                for (int r = 0; r < 16; ++r) gxl[crow32(r, hi) * 128 + 32 * wv + r32] = cg[r]; }
        }
        LDS_BAR();
        const int un = (u + F.G < M / 32) ? u + F.G : u;
        PS_HEAD(un * 32);
#pragma unroll
        for (int k = 0; k < 4; ++k) {
            const int tok = 4 * wv + k, t = t0 + tok; const size_t m = (size_t)m0 + tok;
            float rr[4], kr[4], rp[4], kp[4], hq[4], hz[4];
            BF4(i_rr[k], rr); BF4(i_kr[k], kr); BF4(i_rp[k], rp); BF4(i_kp[k], kp); BF4(i_hq[k], hq); BF4(i_hz[k], hz);
            const f32x4 xw4 = *(const LAS f32x4*)(xwl + tok * 256 + c4), xa4 = *(const LAS f32x4*)(xal + tok * 256 + c4);
            float r[4], kv[4], kk[4], av[4], wv_[4], k2[4];
#pragma unroll
            for (int e = 0; e < 4; ++e) {
                const float rpv = (t > 0) ? rp[e] : 0.f, kpv = (t > 0) ? kp[e] : 0.f;
                r[e] = rr[e] + mur4[e] * (rpv - rr[e]); kv[e] = kr[e] + muk4[e] * (kpv - kr[e]);
                wv_[e] = __expf(-0.606531f * sigmoidf_(w04[e] + xw4[e])); av[e] = sigmoidf_(a04[e] + xa4[e]);
                kk[e] = kv[e] * kkc4[e]; k2[e] = kv[e] * (1.f + (av[e] - 1.f) * kac4[e]); }
            float ss = (kk[0] * kk[0] + kk[1] * kk[1]) + (kk[2] * kk[2] + kk[3] * kk[3]);
            float bs = (r[0] * k2[0] * rkc4[0] + r[1] * k2[1] * rkc4[1]) + (r[2] * k2[2] * rkc4[2] + r[3] * k2[3] * rkc4[3]);
            ROW16(ss); ROW16(bs);
            const float rn = rsqrtf(fmaxf(ss, 1e-24f));
            if ((lane & 15) == 0) ((float*)(F.ws + WS_BS))[m * 4 + hl] = bs;
            float kn[4];
#pragma unroll
            for (int e = 0; e < 4; ++e) kn[e] = kk[e] * rn;
            bf16* dst = RWS + (size_t)((bl * 4 + hl) * SEQ + t) * 320 + cw;
            u32x2 w;
            w.x = pk2(-kn[0], -kn[1]); w.y = pk2(-kn[2], -kn[3]); *(u32x2*)dst = w;
            w.x = pk2(1.f - wv_[0], 1.f - wv_[1]); w.y = pk2(1.f - wv_[2], 1.f - wv_[3]); *(u32x2*)(dst + 64) = w;
            w.x = pk2(kn[0] * av[0], kn[1] * av[1]); w.y = pk2(kn[2] * av[2], kn[3] * av[3]); *(u32x2*)(dst + 128) = w;
            w.x = pk2(k2[0], k2[1]); w.y = pk2(k2[2], k2[3]); *(u32x2*)(dst + 192) = w;
            w.x = pk2(r[0], r[1]); w.y = pk2(r[2], r[3]); *(u32x2*)(dst + 256) = w;
            bf16* hd = HS + (size_t)((bl * 4 + hl) * SEQ + t) * 128 + cw;
            w.x = pk2(hq[0] * sigmoidf_(hq[0]), hq[1] * sigmoidf_(hq[1])); w.y = pk2(hq[2] * sigmoidf_(hq[2]), hq[3] * sigmoidf_(hq[3])); *(u32x2*)hd = w;
            w.x = pk2((1.f - lb4[0]) * sigmoidf_(-hz[0]), (1.f - lb4[1]) * sigmoidf_(-hz[1])); w.y = pk2((1.f - lb4[2]) * sigmoidf_(-hz[2]), (1.f - lb4[3]) * sigmoidf_(-hz[3])); *(u32x2*)(hd + 64) = w;
            PS_LOADT(k, un * 32);
        }
#pragma unroll
        for (int q = 0; q < 2; ++q) {
            const int tok = 4 * wv + 2 * q + tsub, t = t0 + tok;
            float gq[4], gk[4]; BF4(i_gq[q], gq); BF4(i_gk[q], gk);
            const f32x4 gx4 = *(const LAS f32x4*)(gxl + tok * 128 + c4g);
            float od[4];
#pragma unroll
            for (int e = 0; e < 4; ++e) { const float x = gb4[e] + gx4[e];
                const float ls = (x < 0.f ? x : 0.f) - __logf(1.f + __expf(-fabsf(x)));
                od[e] = -expm1f(ls * (1.f / 16.f)); }
            bf16* gd = GS + (size_t)((bl * 4 + h2g) * SEQ + t) * 128 + (c4g & 31);
            u32x2 w;
            w.x = pk2(gq[0] * 0.17677669529663687f, gq[1] * 0.17677669529663687f); w.y = pk2(gq[2] * 0.17677669529663687f, gq[3] * 0.17677669529663687f); *(u32x2*)gd = w;
            *(u32x2*)(gd + 32) = i_gk[q];
            w.x = pk2(od[0], od[1]); w.y = pk2(od[2], od[3]); *(u32x2*)(gd + 64) = w;
            PG_LOADT(q, un * 32);
        }
        LDS_BAR();
    }
#undef PS_HEAD
#undef PS_LOADT
#undef PG_LOADT
#undef BF4
#undef ROW16
}
namespace att {
typedef __attribute__((address_space(3))) const char* lds_cptr;
typedef short v4i16_t __attribute__((ext_vector_type(4)));
typedef float f32x2_t __attribute__((ext_vector_type(2))); typedef __bf16 bf16x2_t __attribute__((ext_vector_type(2)));
constexpr int SLOTB = 8192, LDS_K = 0, LDS_V = 4 * SLOTB, LDS_WS = 8 * SLOTB, LDS_STG = 0, LDS_TOTAL = LDS_WS + 2048;
__device__ __forceinline__ int crow(int r, int hi) { return (r & 3) + 8 * (r >> 2) + 4 * hi; }
__device__ __forceinline__ void glds16(const void* gsrc, unsigned lds_dst) { unsigned keep;
    asm volatile("s_mov_b32 %0, m0\n\ts_mov_b32 m0, %2\n\ts_nop 0\n\tglobal_load_lds_dwordx4 %1, off\n\ts_mov_b32 m0, %0" : "=&s"(keep) : "v"(gsrc), "s"(lds_dst) : "memory"); }
__device__ __forceinline__ unsigned cvtpk_s(float lo, float hi) { f32x2_t v = {lo, hi}; bf16x2_t b = __builtin_convertvector(v, bf16x2_t); return __builtin_bit_cast(unsigned, b); }
__device__ __forceinline__ s16x4 vtr(lds_cptr p) { return __builtin_bit_cast(s16x4, __builtin_amdgcn_ds_read_tr16_b64_v4i16((__attribute__((address_space(3))) v4i16_t*)p)); }
#define ATT_WAIT_BAR() asm volatile("s_waitcnt vmcnt(0) lgkmcnt(0)\n\ts_barrier" ::: "memory")
__device__ __forceinline__ void attn_unit(int b, int h, int qb, bf16* PR, float lam, float ref2, float onemli, const float* gout, char* shm, int wave0) {
    int tid_ = wave0 * 64 + LANE_ID(); asm volatile("" : "+v"(tid_));
    const int tid = tid_, lane = tid & 63, r32 = lane & 31, hi = lane >> 5; const int wid = __builtin_amdgcn_readfirstlane(tid >> 6);
    const long rowbase = (long)b * SEQ; const int q0 = qb * 256;
    const bf16* Qw = PR + (rowbase + q0 + wid * 32) * PINP + SA0 + h * 64;
    const bf16* Kh = PR + rowbase * PINP + SA0 + 256 + h * 64; const bf16* Vh = PR + rowbase * PINP + SA0 + 512 + h * 64;
    const unsigned lds0 = (unsigned)(uintptr_t)shm;
    float* wsf = (float*)(shm + LDS_WS) + wid * 64;
    float* stg = (float*)(shm + LDS_STG) + wid * 2048;
    const bf16* ksrc = Kh + (long)lane * PINP + wid * 8;
    const bf16* vsrc = Vh + (long)(16 * (wid & 3) + (lane >> 2)) * PINP + (wid >> 2) * 32 + (lane & 3) * 8;
    const unsigned kdst = lds0 + LDS_K + wid * 1024, vdst = lds0 + LDS_V + wid * 1024;
#define DMA_K(t, slot) glds16(ksrc + (long)(t) * 64 * PINP, (unsigned)__builtin_amdgcn_readfirstlane(kdst + (slot)))
#define DMA_V(t, slot) glds16(vsrc + (long)(t) * 64 * PINP, (unsigned)__builtin_amdgcn_readfirstlane(vdst + (slot)))
    const lds_cptr shm3 = (lds_cptr)shm;
    const int NT = (q0 + 256) / 64;
    const float slope2 = LOG2E * exp2f(-2.f * (float)(h + 1));
    int t_lo = 0; { const float dmax = (2.f * ref2 + 150.f) / slope2; const float tl = ceilf(((float)(q0 - 63) - dmax) * (1.f / 64.f)); t_lo = tl > 0.f ? (int)tl : 0; t_lo = __builtin_amdgcn_readfirstlane(t_lo); }
    t_lo &= ~1;
    DMA_K(t_lo, ((t_lo >> 1) & 1) * 2 * SLOTB); DMA_V(t_lo, ((t_lo >> 1) & 1) * 2 * SLOTB); DMA_K(t_lo + 1, ((t_lo >> 1) & 1) * 2 * SLOTB + SLOTB); DMA_V(t_lo + 1, ((t_lo >> 1) & 1) * 2 * SLOTB + SLOTB);
    bf16x8 qr[4];
#pragma unroll
    for (int j = 0; j < 4; ++j) qr[j] = *reinterpret_cast<const bf16x8*>(&Qw[(long)r32 * PINP + j * 16 + hi * 8]);
    const int qpos = q0 + wid * 32 + r32;
    float cb[16];
#pragma unroll
    for (int r = 0; r < 16; ++r) cb[r] = slope2 * (float)crow(r, hi);
    float l1 = 0.f, l2 = 0.f; f32x16 o1[2], o2[2];
    o1[0] = f32x16{}; o1[1] = f32x16{}; o2[0] = f32x16{}; o2[1] = f32x16{};
#pragma unroll
    for (int j = 0; j < 4; ++j) asm volatile("" :: "v"(qr[j]));
    for (int tp = t_lo; tp < NT; tp += 2) {
        ATT_WAIT_BAR();
        if (tp + 2 < NT) { const int sn = (((tp + 2) >> 1) & 1) * 2 * SLOTB; DMA_K(tp + 2, sn); DMA_V(tp + 2, sn); DMA_K(tp + 3, sn + SLOTB); DMA_V(tp + 3, sn + SLOTB); }
#pragma unroll 1
      for (int tt = 0; tt < 2; ++tt) {
        const int t = tp + tt;
        const int slot = ((tp >> 1) & 1) * 2 * SLOTB + tt * SLOTB;
        if (64 * t <= q0 + wid * 32 + 31) {
            const lds_cptr kp = shm3 + LDS_K + slot + hi * 1024 + r32 * 16;
            bf16x8 kf[8];
#pragma unroll
            for (int j = 0; j < 4; ++j) { kf[2 * j] = *(const __attribute__((address_space(3))) bf16x8*)(kp + j * 2048); kf[2 * j + 1] = *(const __attribute__((address_space(3))) bf16x8*)(kp + j * 2048 + 512); }
            const float tc = slope2 * (float)(64 * t - qpos) - ref2;
            f32x16 c0, c1;
#pragma unroll
            for (int r = 0; r < 16; ++r) { c0[r] = cb[r] + tc; c1[r] = c0[r] + 32.f * slope2; }
            f32x16 pa0 = __builtin_amdgcn_mfma_f32_32x32x16_bf16(kf[0], qr[0], c0, 0, 0, 0); pa0 = __builtin_amdgcn_mfma_f32_32x32x16_bf16(kf[2], qr[1], pa0, 0, 0, 0);
            f32x16 pa1 = __builtin_amdgcn_mfma_f32_32x32x16_bf16(kf[1], qr[0], c1, 0, 0, 0); pa1 = __builtin_amdgcn_mfma_f32_32x32x16_bf16(kf[3], qr[1], pa1, 0, 0, 0);
            f32x16 pb0 = __builtin_amdgcn_mfma_f32_32x32x16_bf16(kf[4], qr[2], c0, 0, 0, 0); pb0 = __builtin_amdgcn_mfma_f32_32x32x16_bf16(kf[6], qr[3], pb0, 0, 0, 0);
            f32x16 pb1 = __builtin_amdgcn_mfma_f32_32x32x16_bf16(kf[5], qr[2], c1, 0, 0, 0); pb1 = __builtin_amdgcn_mfma_f32_32x32x16_bf16(kf[7], qr[3], pb1, 0, 0, 0);
#pragma unroll
            for (int r = 0; r < 16; ++r) { pa0[r] = __builtin_amdgcn_exp2f(pa0[r]); pa1[r] = __builtin_amdgcn_exp2f(pa1[r]); pb0[r] = __builtin_amdgcn_exp2f(pb0[r]); pb1[r] = __builtin_amdgcn_exp2f(pb1[r]); }
            if (64 * t + 63 > q0 + wid * 32) {
#pragma unroll
                for (int r = 0; r < 16; ++r) { const int kv = 64 * t + crow(r, hi);
                    if (kv > qpos) { pa0[r] = 0.f; pb0[r] = 0.f; }
                    if (kv + 32 > qpos) { pa1[r] = 0.f; pb1[r] = 0.f; } }
            }
            float sa = 0.f, sb = 0.f;
#pragma unroll
            for (int r = 0; r < 16; ++r) { sa += pa0[r] + pa1[r]; sb += pb0[r] + pb1[r]; }
            l1 += sa; l2 += sb;
            u32x4 pw[4], qw[4];
#pragma unroll
            for (int i = 0; i < 4; ++i) { pw[0][i] = cvtpk_s(pa0[2 * i], pa0[2 * i + 1]); pw[1][i] = cvtpk_s(pa0[8 + 2 * i], pa0[9 + 2 * i]); pw[2][i] = cvtpk_s(pa1[2 * i], pa1[2 * i + 1]); pw[3][i] = cvtpk_s(pa1[8 + 2 * i], pa1[9 + 2 * i]);
                qw[0][i] = cvtpk_s(pb0[2 * i], pb0[2 * i + 1]); qw[1][i] = cvtpk_s(pb0[8 + 2 * i], pb0[9 + 2 * i]); qw[2][i] = cvtpk_s(pb1[2 * i], pb1[2 * i + 1]); qw[3][i] = cvtpk_s(pb1[8 + 2 * i], pb1[9 + 2 * i]); }
            const lds_cptr vp = shm3 + LDS_V + slot + ((lane >> 4) & 1) * 32 + (lane & 3) * 8 + (4 * hi + ((lane & 15) >> 2)) * 64;
#pragma unroll
            for (int d0 = 0; d0 < 2; ++d0) {
#pragma unroll
                for (int k = 0; k < 4; ++k) {
                    const s16x4 vlo = vtr(vp + d0 * 4096 + k * 1024), vhi = vtr(vp + d0 * 4096 + k * 1024 + 512);
                    const bf16x8 vf = (bf16x8){vlo[0], vlo[1], vlo[2], vlo[3], vhi[0], vhi[1], vhi[2], vhi[3]};
                    o1[d0] = __builtin_amdgcn_mfma_f32_32x32x16_bf16(__builtin_bit_cast(bf16x8, pw[k]), vf, o1[d0], 0, 0, 0);
                    o2[d0] = __builtin_amdgcn_mfma_f32_32x32x16_bf16(__builtin_bit_cast(bf16x8, qw[k]), vf, o2[d0], 0, 0, 0);
                }
            }
        }
      }
    }
    ATT_WAIT_BAR();
    { auto r1 = __builtin_amdgcn_permlane32_swap(__float_as_uint(l1), __float_as_uint(l1), false, false); l1 = __uint_as_float(r1[0]) + __uint_as_float(r1[1]);
      auto r2 = __builtin_amdgcn_permlane32_swap(__float_as_uint(l2), __float_as_uint(l2), false, false); l2 = __uint_as_float(r2[0]) + __uint_as_float(r2[1]); }
    if (hi == 0) { wsf[r32] = 1.f / l1; wsf[32 + r32] = lam / l2; }
    asm volatile("s_waitcnt lgkmcnt(0)" ::: "memory");
#pragma unroll
    for (int r = 0; r < 16; ++r) { const int orow = crow(r, hi); const float a1 = wsf[orow], a2 = wsf[32 + orow];
#pragma unroll
        for (int d0 = 0; d0 < 2; ++d0) stg[orow * 64 + d0 * 32 + r32] = o1[d0][r] * a1 - o2[d0][r] * a2; }
    asm volatile("s_waitcnt lgkmcnt(0)" ::: "memory");
    bf16* Ow = PR + (rowbase + q0 + wid * 32) * PINP + SA0 + h * 64;
#pragma unroll
    for (int i = 0; i < 4; ++i) { const int row = i * 8 + (lane >> 3), ch = lane & 7;
        const f32x4 x0 = *(const f32x4*)(stg + row * 64 + ch * 8), x1 = *(const f32x4*)(stg + row * 64 + ch * 8 + 4);
        float s = (x0.x * x0.x + x0.y * x0.y) + (x0.z * x0.z + x0.w * x0.w) + (x1.x * x1.x + x1.y * x1.y) + (x1.z * x1.z + x1.w * x1.w);
        s += __shfl_xor(s, 1); s += __shfl_xor(s, 2); s += __shfl_xor(s, 4);
        const float rs = RS_EPS(s, 1.f / 64.f, 64e-6f) * onemli;
        const f32x4 g0 = *(const f32x4*)(gout + ch * 8), g1 = *(const f32x4*)(gout + ch * 8 + 4);
        u32x4 w; w.x = pk2(x0.x * rs * g0.x, x0.y * rs * g0.y); w.y = pk2(x0.z * rs * g0.z, x0.w * rs * g0.w); w.z = pk2(x1.x * rs * g1.x, x1.y * rs * g1.y); w.w = pk2(x1.z * rs * g1.z, x1.w * rs * g1.w);
        *(u32x4*)(Ow + (long)row * PINP + ch * 8) = w; }
    asm volatile("s_waitcnt lgkmcnt(0)\n\ts_barrier" ::: "memory");
#undef DMA_K
#undef DMA_V
}
}
__device__ __forceinline__ void attn_phase(Frame& F, const Args& A, int l, char* lds) {
    const float lam = ((float*)(F.ws + WS_LC))[l * 16 + 0], lam_init = ((float*)(F.ws + WS_LC))[l * 16 + 1], ref2 = ((float*)(F.ws + WS_LC))[l * 16 + 2];
    if (F.wave >= 4) __builtin_amdgcn_s_setprio(1);
    for (int v = F.vcu; v < 256; v += F.G) {
        const int b = v >> 5, s = v & 31;
        for (int i = 0; i < 4; ++i) {
            const int h = 3 - i, qb = (i & 1) ? 31 - s : s;
            att::attn_unit(b, h, qb, ((bf16*)(F.ws + WS_PR)), lam, ref2, 1.f - lam_init, A.in[9] + l * 64, lds, F.wave);
        }
    }
    __builtin_amdgcn_s_setprio(0);
}
constexpr int NSR = 128, LR = SEQ / NSR, NSH = 64, LH = SEQ / NSH, NSG = 32, LG = SEQ / NSG;
constexpr size_t CRW_S = 0, CRW_P = 64 * MiB, CRW_T = 96 * MiB, CH_S = 128 * MiB, CH_T = 160 * MiB, CG_S = 176 * MiB, CG_T = 184 * MiB, CH_G = 188 * MiB, CG_G = 189 * MiB;
typedef float f32x2 __attribute__((ext_vector_type(2)));
#define PK_MUL(d, a, b) (d) = (a) * (b)
#define PK_FMA(acc, a, b) (acc) = __builtin_elementwise_fma((a), (b), (acc))
#define PK_FMA_BL(acc, a, b) (acc) = __builtin_elementwise_fma((f32x2){(a).x, (a).x}, (b), (acc))
#define PK_FMA_BH(acc, a, b) (acc) = __builtin_elementwise_fma((f32x2){(a).y, (a).y}, (b), (acc))
#define PK_BSUB(d, a, b) (d) = (f32x2){(a).x, (a).x} - (b)
#define XY(v) ((f32x2){(v).x, (v).y})
#define ZW(v) ((f32x2){(v).z, (v).w})
constexpr int SCAN_LDS_PER_WAVE = 4096;
__device__ __forceinline__ void unpack8(const v4u r, float (&f)[8]) {
#pragma unroll
    for (int i = 0; i < 4; ++i) { f[2 * i] = __builtin_bit_cast(float, r[i] << 16); f[2 * i + 1] = __builtin_bit_cast(float, r[i] & 0xffff0000u); }
}
__device__ __forceinline__ void scan_rwkv(Frame& F, const Args& A, int l, int b, int h, int seg) {
    int lane_ = lane_id(); asm volatile("" : "+v"(lane_));
    const int lane = lane_, ts = seg * LR;
    const bf16* recb = (const bf16*)(F.ws + WS_SC + SC_RWS) + (size_t)((b * 4 + h) * SEQ + ts) * 320;
    const v4u* rec = (const v4u*)recb + (lane < 40 ? lane : 39);
    LAS float* ring = (LAS float*)(F.lds + RING_OFF + F.wave * 16384);
    const bf16* vcol = ((bf16*)(F.ws + WS_PR)) + ((size_t)b * SEQ + ts) * PINP + SD0 + 512 + h * 64 + lane;
    bf16* ycol = ((bf16*)(F.ws + WS_PR)) + ((size_t)b * SEQ + ts) * PINP + SD0 + h * 64 + lane;
    const float mu_v = A.in[15][l * 896 + 512 + h * 64 + lane];
    const bool wl = (lane >= 8 && lane < 16);
    f32x2 S2[32], P2[32];
#pragma unroll
    for (int i = 0; i < 32; ++i) { S2[i] = (f32x2){0.f, 0.f}; P2[i] = (f32x2){(2 * i == lane) ? 1.f : 0.f, (2 * i + 1 == lane) ? 1.f : 0.f}; }
    float vprev = (ts > 0) ? bf2f(*(vcol - PINP)) : 0.f;
    constexpr int PD = 2;
    v4u rq[PD]; float vq[PD];
#pragma unroll
    for (int j = 0; j < PD; ++j) { rq[j] = rec[j * 40]; vq[j] = bf2f(vcol[(size_t)j * PINP]); }
    for (int t0 = 0; t0 < LR; t0 += PD) {
#pragma unroll
        for (int j = 0; j < PD; ++j) {
            const int t = t0 + j;
            LAS float* slot = ring + (j & 1) * 512;
            { float f[8]; unpack8(rq[j], f);
#pragma unroll
              for (int i = 0; i < 8; ++i) f[i] = wl ? 1.f - f[i] : f[i];
              if (lane < 40) { *(LAS f32x4*)(slot + 8 * lane) = (f32x4){f[0], f[1], f[2], f[3]}; *(LAS f32x4*)(slot + 8 * lane + 4) = (f32x4){f[4], f[5], f[6], f[7]}; } }
            const float vr = vq[j];
            { const int tn = (t + PD < LR) ? t + PD : LR - 1; rq[j] = rec[(size_t)tn * 40]; vq[j] = bf2f(vcol[(size_t)tn * PINP]); }
            const float v = vr + mu_v * (vprev - vr); vprev = vr;
            f32x2 sA0 = {0.f, 0.f}, sA1 = {0.f, 0.f}, pA0 = {0.f, 0.f}, pA1 = {0.f, 0.f};
#pragma unroll
            for (int g = 0; g < 16; ++g) { const f32x4 a = *(const LAS f32x4*)(slot + 4 * g); const f32x2 alo = XY(a), ahi = ZW(a);
                PK_FMA(sA0, S2[2 * g], alo); PK_FMA(pA0, P2[2 * g], alo); PK_FMA(sA1, S2[2 * g + 1], ahi); PK_FMA(pA1, P2[2 * g + 1], ahi); }
            const f32x2 sp = {(sA0.x + sA0.y) + (sA1.x + sA1.y), (pA0.x + pA0.y) + (pA1.x + pA1.y)};
            const f32x2 vv = {v, v};
            f32x2 yA0 = {0.f, 0.f}, yA1 = {0.f, 0.f}, zA0 = {0.f, 0.f}, zA1 = {0.f, 0.f};
#pragma unroll
            for (int g = 0; g < 16; ++g) {
                const f32x4 w = *(const LAS f32x4*)(slot + 64 + 4 * g), bb = *(const LAS f32x4*)(slot + 128 + 4 * g), kk = *(const LAS f32x4*)(slot + 192 + 4 * g), r = *(const LAS f32x4*)(slot + 256 + 4 * g);
                const f32x2 wl2 = XY(w), wh2 = ZW(w), bl2 = XY(bb), bh2 = ZW(bb), kl2 = XY(kk), kh2 = ZW(kk), rl2 = XY(r), rh2 = ZW(r);
                PK_MUL(S2[2 * g], S2[2 * g], wl2); PK_MUL(S2[2 * g + 1], S2[2 * g + 1], wh2); PK_MUL(P2[2 * g], P2[2 * g], wl2); PK_MUL(P2[2 * g + 1], P2[2 * g + 1], wh2);
                PK_FMA_BL(S2[2 * g], sp, bl2); PK_FMA_BL(S2[2 * g + 1], sp, bh2); PK_FMA_BH(P2[2 * g], sp, bl2); PK_FMA_BH(P2[2 * g + 1], sp, bh2);
                PK_FMA_BL(S2[2 * g], vv, kl2); PK_FMA_BL(S2[2 * g + 1], vv, kh2);
                PK_FMA(zA0, P2[2 * g], rl2); PK_FMA(zA1, P2[2 * g + 1], rh2); PK_FMA(yA0, S2[2 * g], rl2); PK_FMA(yA1, S2[2 * g + 1], rh2); }
            ycol[(size_t)t * PINP] = (bf16)f2bf((yA0.x + yA0.y) + (yA1.x + yA1.y));
            ycol[(size_t)t * PINP + 256] = (bf16)f2bf((zA0.x + zA0.y) + (zA1.x + zA1.y));
        }
    }
    int lane2 = lane; asm volatile("" : "+v"(lane2));
    const size_t item = (size_t)((b * 4 + h) * NSR + seg);
    float* so = (float*)((unsigned char*)F.out + CRW_S) + item * 4096 + lane2;
    bf16* po = (bf16*)((unsigned char*)F.out + CRW_P) + item * 4096 + lane2;
#pragma unroll
    for (int k = 0; k < 64; ++k) { so[k * 64] = S2[k >> 1][k & 1]; po[k * 64] = (bf16)f2bf(P2[k >> 1][k & 1]); }
}
__device__ __forceinline__ void scan_hgrn(Frame& F, int b, int h, int seg) {
    int lane_ = lane_id(); asm volatile("" : "+v"(lane_));
    const int lane = lane_, ts = seg * LH;
    const bf16* recb = (const bf16*)(F.ws + WS_SC + SC_HS) + (size_t)((b * 4 + h) * SEQ + ts) * 128;
    const v4u* rec = (const v4u*)recb + (lane & 15);
    LAS float* ring = (LAS float*)(F.lds + RING_OFF + F.wave * 16384);
    const bf16* vcol = ((bf16*)(F.ws + WS_PR)) + ((size_t)b * SEQ + ts) * PINP + SC0 + 512 + h * 64 + lane;
    bf16* ycol = ((bf16*)(F.ws + WS_PR)) + ((size_t)b * SEQ + ts) * PINP + SC0 + h * 64 + lane;
    f32x2 S2[32];
#pragma unroll
    for (int i = 0; i < 32; ++i) S2[i] = (f32x2){0.f, 0.f};
    float gam = 1.f;
    constexpr int PD = 4;
    v4u rq[PD]; float vq[PD];
#pragma unroll
    for (int j = 0; j < PD; ++j) { rq[j] = rec[j * 16]; vq[j] = bf2f(vcol[(size_t)j * PINP]); }
    for (int t0 = 0; t0 < LH; t0 += PD) {
#pragma unroll
        for (int j = 0; j < PD; ++j) {
            const int t = t0 + j;
            LAS float* slot = ring + (j & 1) * 512;
            { float f[8]; unpack8(rq[j], f);
              if (lane < 16) { *(LAS f32x4*)(slot + 8 * lane) = (f32x4){f[0], f[1], f[2], f[3]}; *(LAS f32x4*)(slot + 8 * lane + 4) = (f32x4){f[4], f[5], f[6], f[7]}; } }
            const float v = vq[j];
            { const int tn = (t + PD < LH) ? t + PD : LH - 1; rq[j] = rec[(size_t)tn * 16]; vq[j] = bf2f(vcol[(size_t)tn * PINP]); }
            const f32x2 vv = {v, v}; f32x2 yA0 = {0.f, 0.f}, yA1 = {0.f, 0.f};
#pragma unroll
            for (int g = 0; g < 16; ++g) { const f32x4 q = *(const LAS f32x4*)(slot + 4 * g), kk = *(const LAS f32x4*)(slot + 64 + 4 * g);
                f32x2 d0, d1; PK_BSUB(d0, vv, S2[2 * g]); PK_BSUB(d1, vv, S2[2 * g + 1]);
                PK_FMA(S2[2 * g], XY(kk), d0); PK_FMA(S2[2 * g + 1], ZW(kk), d1);
                PK_FMA(yA0, XY(q), S2[2 * g]); PK_FMA(yA1, ZW(q), S2[2 * g + 1]); }
            const float ql = slot[lane], kl = slot[64 + lane];
            gam *= (1.f - kl);
            ycol[(size_t)t * PINP] = (bf16)f2bf((yA0.x + yA0.y) + (yA1.x + yA1.y));
            ycol[(size_t)t * PINP + 256] = (bf16)f2bf(ql * gam);
        }
    }
    int lane2 = lane; asm volatile("" : "+v"(lane2));
    const size_t item = (size_t)((b * 4 + h) * NSH + seg);
    float* so = (float*)((unsigned char*)F.out + CH_S) + item * 4096 + lane2;
#pragma unroll
    for (int k = 0; k < 64; ++k) so[k * 64] = S2[k >> 1][k & 1];
    ((float*)((unsigned char*)F.out + CH_G))[item * 64 + lane2] = gam;
}
__device__ __forceinline__ void scan_gla(Frame& F, int b, int h, int seg) {
    int lane_ = lane_id(); asm volatile("" : "+v"(lane_));
    const int lane = lane_, ts = seg * LG, kl = lane & 31;
    const bf16* recb = (const bf16*)(F.ws + WS_SC + SC_GS) + (size_t)((b * 4 + h) * SEQ + ts) * 128;
    const v4u* rec = (const v4u*)recb + (lane & 15);
    LAS float* ring = (LAS float*)(F.lds + RING_OFF + F.wave * 16384);
    const bf16* vcol = ((bf16*)(F.ws + WS_PR)) + ((size_t)b * SEQ + ts) * PINP + SB0 + 256 + h * 64 + lane;
    bf16* ycol = ((bf16*)(F.ws + WS_PR)) + ((size_t)b * SEQ + ts) * PINP + SB0 + h * 64 + lane;
    bf16* zcol = ((bf16*)(F.ws + WS_ZG)) + ((size_t)b * SEQ + ts) * 128 + h * 32 + kl;
    const bool al = (lane >= 8 && lane < 12);
    f32x2 S2[16];
#pragma unroll
    for (int i = 0; i < 16; ++i) S2[i] = (f32x2){0.f, 0.f};
    float gam = 1.f;
    constexpr int PD = 8;
    v4u rq[PD]; float vq[PD];
#pragma unroll
    for (int j = 0; j < PD; ++j) { rq[j] = rec[j * 16]; vq[j] = bf2f(vcol[(size_t)j * PINP]); }
    for (int t0 = 0; t0 < LG; t0 += PD) {
#pragma unroll
        for (int j = 0; j < PD; ++j) {
            const int t = t0 + j;
            LAS float* slot = ring + (j & 1) * 512;
            { float f[8]; unpack8(rq[j], f);
#pragma unroll
              for (int i = 0; i < 8; ++i) f[i] = al ? 1.f - f[i] : f[i];
              if (lane < 12) { *(LAS f32x4*)(slot + 8 * lane) = (f32x4){f[0], f[1], f[2], f[3]}; *(LAS f32x4*)(slot + 8 * lane + 4) = (f32x4){f[4], f[5], f[6], f[7]}; } }
            const float v = vq[j];
            { const int tn = (t + PD < LG) ? t + PD : LG - 1; rq[j] = rec[(size_t)tn * 16]; vq[j] = bf2f(vcol[(size_t)tn * PINP]); }
            const f32x2 vv = {v, v}; f32x2 yA0 = {0.f, 0.f}, yA1 = {0.f, 0.f};
#pragma unroll
            for (int g = 0; g < 8; ++g) { const f32x4 q = *(const LAS f32x4*)(slot + 4 * g), kk = *(const LAS f32x4*)(slot + 32 + 4 * g), a = *(const LAS f32x4*)(slot + 64 + 4 * g);
                PK_MUL(S2[2 * g], S2[2 * g], XY(a)); PK_MUL(S2[2 * g + 1], S2[2 * g + 1], ZW(a));
                PK_FMA_BL(S2[2 * g], vv, XY(kk)); PK_FMA_BL(S2[2 * g + 1], vv, ZW(kk));
                PK_FMA(yA0, XY(q), S2[2 * g]); PK_FMA(yA1, ZW(q), S2[2 * g + 1]); }
            const float ql = slot[kl], av = slot[64 + kl];
            gam *= av;
            ycol[(size_t)t * PINP] = (bf16)f2bf((yA0.x + yA0.y) + (yA1.x + yA1.y));
            if (lane < 32) zcol[(size_t)t * 128] = (bf16)f2bf(ql * gam);
        }
    }
    int lane2 = lane; asm volatile("" : "+v"(lane2));
    const size_t item = (size_t)((b * 4 + h) * NSG + seg);
    float* so = (float*)((unsigned char*)F.out + CG_S) + item * 2048 + lane2;
#pragma unroll
    for (int k = 0; k < 32; ++k) so[k * 64] = S2[k >> 1][k & 1];
    if (lane2 < 32) ((float*)((unsigned char*)F.out + CG_G))[item * 32 + lane2] = gam;
}
template <int CTRL, int RM> __device__ __forceinline__ float dppz(float v) { return __builtin_bit_cast(float, __builtin_amdgcn_update_dpp(0, __builtin_bit_cast(int, v), CTRL, RM, 0xf, true)); }
__device__ __forceinline__ float scan32(float v) {
    v += dppz<0x111, 0xf>(v); v += dppz<0x112, 0xf>(v); v += dppz<0x114, 0xf>(v); v += dppz<0x118, 0xf>(v);
    v += dppz<0x142, 0xa>(v);
    return v;
}
template <int KD, bool GLA> __device__ __forceinline__ void chunk_scan(Frame& F, int b, int h, int seg) {
    constexpr int NC = KD / 16, NKT = KD / 32, L = GLA ? LG : LH, NS = GLA ? NSG : NSH, KOFF = GLA ? 32 : 64, DOFF = 64;
    int lane_ = lane_id(); asm volatile("" : "+v"(lane_));
    const int lane = lane_, r32 = lane & 31, hi = lane >> 5, ts = seg * L;
    const bf16* recb = (const bf16*)(F.ws + WS_SC + (GLA ? SC_GS : SC_HS)) + (size_t)((b * 4 + h) * SEQ + ts) * 128;
    const size_t mrow = (size_t)b * SEQ + ts;
    const bf16* vbase = ((bf16*)(F.ws + WS_PR)) + mrow * PINP + (GLA ? SB0 + 256 : SC0 + 512) + h * 64;
    bf16* ybase = ((bf16*)(F.ws + WS_PR)) + mrow * PINP + (GLA ? SB0 : SC0) + h * 64;
    bf16* zbase = GLA ? ((bf16*)(F.ws + WS_ZG)) + mrow * 128 + h * 32 : ((bf16*)(F.ws + WS_PR)) + mrow * PINP + SC0 + 256 + h * 64;
    constexpr int ZP = GLA ? 128 : PINP;
    LAS unsigned char* vimg = F.lds + RING_OFF + F.wave * 16384;
    LAS unsigned char* kimg = vimg + 8192;
    const att::lds_cptr vrd = (att::lds_cptr)vimg + ((lane >> 4) & 1) * 32 + (lane & 3) * 8 + (4 * hi + ((lane & 15) >> 2)) * 64;
    const att::lds_cptr krd = vrd + 8192;
    f32x16 S[NKT][2];
#pragma unroll
    for (int kt = 0; kt < NKT; ++kt) { S[kt][0] = f32x16{}; S[kt][1] = f32x16{}; }
    LAS float* Bprev = (LAS float*)(F.lds + MISC_OFF + 1024 + F.wave * 512) + hi * 32;
    LAS float* Bend = Bprev + 64;
    if (r32 == 0) {
#pragma unroll
        for (int i = 0; i < NC * 8; ++i) Bprev[i] = 0.f; }
    for (int ch = 0; ch < L / 64; ++ch) {
        const int tc = ch * 64;
        int lc_ = lane; asm volatile("" : "+v"(lc_)); const int r32 = lc_ & 31, hi = lc_ >> 5;
        u32x2 rq[2][6];
#define CS_LOAD(bf_, c_, T_) do { const int k0_ = 32 * ((c_) >> 1) + 16 * ((c_) & 1) + 4 * hi; const bf16* rp_ = recb + (size_t)(tc + 32 * (T_) + r32) * 128; \
            rq[bf_][0] = *(const u32x2*)(rp_ + k0_); rq[bf_][1] = *(const u32x2*)(rp_ + k0_ + 8); rq[bf_][2] = *(const u32x2*)(rp_ + KOFF + k0_); rq[bf_][3] = *(const u32x2*)(rp_ + KOFF + k0_ + 8); \
            rq[bf_][4] = *(const u32x2*)(rp_ + DOFF + k0_); rq[bf_][5] = *(const u32x2*)(rp_ + DOFF + k0_ + 8); } while (0)
        { const int cn = lane & 7, s0 = lane >> 3; const bf16* vp = vbase + (size_t)(tc + s0) * PINP + cn * 8; LAS unsigned char* vw = vimg + (cn >> 2) * 4096 + s0 * 64 + (cn & 3) * 16;
          v4u x[8];
#pragma unroll
          for (int i = 0; i < 8; ++i) { x[i] = *(const v4u*)vp; vp += 8 * PINP; }
          CS_LOAD(0, 0, 0);
          __builtin_amdgcn_sched_barrier(0);
#pragma unroll
          for (int i = 0; i < 8; ++i) *(LAS v4u*)(vw + i * 512) = x[i]; }
        bf16x8 Qh[2][NC];
#pragma unroll
        for (int c = 0; c < NC; ++c) {
            const int k0 = 32 * (c >> 1) + 16 * (c & 1) + 4 * hi;
            float carry[8];
#pragma unroll
            for (int j = 0; j < 8; ++j) carry[j] = 0.f;
#pragma unroll
            for (int T = 0; T < 2; ++T) {
                constexpr int dummy0_ = 0; (void)dummy0_;
                const int idx = 2 * c + T;
                if (idx + 1 < 2 * NC) { if (T == 0) CS_LOAD((idx + 1) & 1, c, 1); else CS_LOAD((idx + 1) & 1, c + 1, 0); }
                __builtin_amdgcn_sched_barrier(0);
                const u32x2 qa = rq[idx & 1][0], qb = rq[idx & 1][1], ka = rq[idx & 1][2], kb = rq[idx & 1][3], da = rq[idx & 1][4], db = rq[idx & 1][5];
                float q[8], kk[8], d[8];
#define UNP(dst, a2, b2) dst[0] = __builtin_bit_cast(float, a2.x << 16); dst[1] = __builtin_bit_cast(float, a2.x & 0xffff0000u); dst[2] = __builtin_bit_cast(float, a2.y << 16); dst[3] = __builtin_bit_cast(float, a2.y & 0xffff0000u); \
                dst[4] = __builtin_bit_cast(float, b2.x << 16); dst[5] = __builtin_bit_cast(float, b2.x & 0xffff0000u); dst[6] = __builtin_bit_cast(float, b2.y << 16); dst[7] = __builtin_bit_cast(float, b2.y & 0xffff0000u);
                UNP(q, qa, qb) UNP(kk, ka, kb) UNP(d, da, db)
#undef UNP
                float qh[8], kh[8], zz[8];
#pragma unroll
                for (int j = 0; j < 8; ++j) {
                    const float g = __logf(1.f - d[j]);
                    const float Bv = scan32(g) + carry[j];
                    const float tot = __shfl(Bv, (lane & 32) | 31);
                    if (T == 0) carry[j] = tot; else if (r32 == 0) Bend[c * 8 + j] = tot;
                    qh[j] = q[j] * __expf(Bv); kh[j] = kk[j] * __expf(fminf(-Bv, 80.f)); zz[j] = q[j] * __expf(Bv + Bprev[c * 8 + j]);
                }
                u32x4 qp; qp.x = pk2(qh[0], qh[1]); qp.y = pk2(qh[2], qh[3]); qp.z = pk2(qh[4], qh[5]); qp.w = pk2(qh[6], qh[7]);
                Qh[T][c] = __builtin_bit_cast(bf16x8, qp);
                const int s = 32 * T + r32;
                LAS unsigned char* kw = kimg + (c >> 1) * 4096 + s * 64 + (k0 & 31) * 2;
                *(LAS u32x2*)kw = (u32x2){pk2(kh[0], kh[1]), pk2(kh[2], kh[3])}; *(LAS u32x2*)(kw + 16) = (u32x2){pk2(kh[4], kh[5]), pk2(kh[6], kh[7])};
                bf16* zw = zbase + (size_t)(tc + s) * ZP + k0;
                *(u32x2*)zw = (u32x2){pk2(zz[0], zz[1]), pk2(zz[2], zz[3])}; *(u32x2*)(zw + 8) = (u32x2){pk2(zz[4], zz[5]), pk2(zz[6], zz[7])};
            }
        }
#undef CS_LOAD
#pragma unroll
        for (int tT = 0; tT < 2; ++tT) {
            f32x16 O[2]; O[0] = f32x16{}; O[1] = f32x16{};
#pragma unroll
            for (int c = 0; c < NC; ++c)
#pragma unroll
                for (int vt = 0; vt < 2; ++vt) { const f32x16& St = S[c >> 1][vt]; const int o = 8 * (c & 1);
                    u32x4 sp; sp.x = pk2(St[o], St[o + 1]); sp.y = pk2(St[o + 2], St[o + 3]); sp.z = pk2(St[o + 4], St[o + 5]); sp.w = pk2(St[o + 6], St[o + 7]);
                    O[vt] = __builtin_amdgcn_mfma_f32_32x32x16_bf16(Qh[tT][c], __builtin_bit_cast(bf16x8, sp), O[vt], 0, 0, 0); }
#pragma unroll
            for (int sT = 0; sT <= tT; ++sT) {
                f32x16 ST = f32x16{};
#pragma unroll
                for (int c = 0; c < NC; ++c) { const int k0 = 32 * (c >> 1) + 16 * (c & 1) + 4 * hi;
                    const LAS unsigned char* kr = kimg + (c >> 1) * 4096 + (32 * sT + r32) * 64 + (k0 & 31) * 2;
                    const u32x2 a0 = *(const LAS u32x2*)kr, a1 = *(const LAS u32x2*)(kr + 16);
                    const u32x4 a4 = {a0.x, a0.y, a1.x, a1.y};
                    ST = __builtin_amdgcn_mfma_f32_32x32x16_bf16(__builtin_bit_cast(bf16x8, a4), Qh[tT][c], ST, 0, 0, 0); }
                if (sT == tT) { int dl = r32 - 4 * hi; asm volatile("" : "+v"(dl));
#pragma unroll
                    for (int r = 0; r < 16; ++r) if ((r & 3) + 8 * (r >> 2) > dl) ST[r] = 0.f;
                }
#pragma unroll
                for (int half = 0; half < 2; ++half) { const int o = 8 * half;
                    u32x4 pw; pw.x = pk2(ST[o], ST[o + 1]); pw.y = pk2(ST[o + 2], ST[o + 3]); pw.z = pk2(ST[o + 4], ST[o + 5]); pw.w = pk2(ST[o + 6], ST[o + 7]);
#pragma unroll
                    for (int vt = 0; vt < 2; ++vt) { const int blk = 2 * sT + half;
                        const s16x4 vlo = att::vtr(vrd + vt * 4096 + blk * 1024), vhi = att::vtr(vrd + vt * 4096 + blk * 1024 + 512);
                        const bf16x8 vf = (bf16x8){vlo[0], vlo[1], vlo[2], vlo[3], vhi[0], vhi[1], vhi[2], vhi[3]};
                        O[vt] = __builtin_amdgcn_mfma_f32_32x32x16_bf16(__builtin_bit_cast(bf16x8, pw), vf, O[vt], 0, 0, 0); } }
            }
            { bf16* yp = ybase + (size_t)(tc + 32 * tT + 4 * hi) * PINP + r32;
#pragma unroll
              for (int r = 0; r < 16; ++r) { yp[0] = (bf16)f2bf(O[0][r]); yp[32] = (bf16)f2bf(O[1][r]); yp += ((r & 3) == 3 ? 5 : 1) * PINP; } }
        }
#pragma unroll
        for (int kt = 0; kt < NKT; ++kt)
#pragma unroll
            for (int vt = 0; vt < 2; ++vt) { f32x16 acc = S[kt][vt];
#pragma unroll
                for (int blk = 0; blk < 4; ++blk) {
                    const s16x4 klo = att::vtr(krd + kt * 4096 + blk * 1024), khi = att::vtr(krd + kt * 4096 + blk * 1024 + 512);
                    const s16x4 vlo = att::vtr(vrd + vt * 4096 + blk * 1024), vhi = att::vtr(vrd + vt * 4096 + blk * 1024 + 512);
                    const bf16x8 kf = (bf16x8){klo[0], klo[1], klo[2], klo[3], khi[0], khi[1], khi[2], khi[3]}, vf = (bf16x8){vlo[0], vlo[1], vlo[2], vlo[3], vhi[0], vhi[1], vhi[2], vhi[3]};
                    acc = __builtin_amdgcn_mfma_f32_32x32x16_bf16(kf, vf, acc, 0, 0, 0); }
#pragma unroll
                for (int r = 0; r < 16; ++r) acc[r] *= __expf(Bend[(2 * kt + (r >> 3)) * 8 + (r & 7)]);
                S[kt][vt] = acc; }
        if (r32 == 0) {
#pragma unroll
            for (int i = 0; i < NC * 8; ++i) Bprev[i] += Bend[i]; }
    }
    int lane2 = lane; asm volatile("" : "+v"(lane2));
    const int r32b = lane2 & 31, hib = lane2 >> 5;
    const size_t item = (size_t)((b * 4 + h) * NS + seg);
    float* so = (float*)((unsigned char*)F.out + (GLA ? CG_S : CH_S)) + item * (KD * 64);
#pragma unroll
    for (int kt = 0; kt < NKT; ++kt)
#pragma unroll
        for (int vt = 0; vt < 2; ++vt)
#pragma unroll
            for (int r = 0; r < 16; ++r) so[(32 * kt + crow32(r, hib)) * 64 + 32 * vt + r32b] = S[kt][vt][r];
    if (r32b == 0) { float* go = (float*)((unsigned char*)F.out + (GLA ? CG_G : CH_G)) + item * KD;
#pragma unroll
        for (int c = 0; c < NC; ++c)
#pragma unroll
            for (int j = 0; j < 8; ++j) go[32 * (c >> 1) + crow32(j + 8 * (c & 1), hib)] = __expf(Bprev[c * 8 + j]); }
}
template <bool WA, bool WR, bool WB, bool WK>
__device__ __forceinline__ void rw_ops(const bf16* recb, int r32, int hi, int lane, bf16x8 (&At)[2][4], bf16x8 (&Rt)[2][4], bf16x8 (&Bb)[2][4], bf16x8 (&Kb)[2][4], LAS float* bend, bool wbend) {
#define RW_UNP(dst, a2, b2) dst[0] = __builtin_bit_cast(float, a2.x << 16); dst[1] = __builtin_bit_cast(float, a2.x & 0xffff0000u); dst[2] = __builtin_bit_cast(float, a2.y << 16); dst[3] = __builtin_bit_cast(float, a2.y & 0xffff0000u); \
    dst[4] = __builtin_bit_cast(float, b2.x << 16); dst[5] = __builtin_bit_cast(float, b2.x & 0xffff0000u); dst[6] = __builtin_bit_cast(float, b2.y << 16); dst[7] = __builtin_bit_cast(float, b2.y & 0xffff0000u);
#define RW_PK(dst, f) { u32x4 p_; p_.x = pk2(f[0], f[1]); p_.y = pk2(f[2], f[3]); p_.z = pk2(f[4], f[5]); p_.w = pk2(f[6], f[7]); dst = __builtin_bit_cast(bf16x8, p_); }
#pragma unroll
    for (int cp = 0; cp < 2; ++cp) {
        u32x2 rd[2][2][2], ra[2][2][2], rr[2][2][2], rb[2][2][2], rk[2][2][2];
#pragma unroll
        for (int ci = 0; ci < 2; ++ci)
#pragma unroll
            for (int T = 0; T < 2; ++T) { const int c = 2 * cp + ci, k0 = 32 * (c >> 1) + 16 * (c & 1) + 4 * hi;
                const bf16* rp = recb + (size_t)(32 * T + r32) * 320 + k0;
                rd[ci][T][0] = *(const u32x2*)(rp + 64); rd[ci][T][1] = *(const u32x2*)(rp + 72);
                if (WA) { ra[ci][T][0] = *(const u32x2*)(rp); ra[ci][T][1] = *(const u32x2*)(rp + 8); }
                if (WR) { rr[ci][T][0] = *(const u32x2*)(rp + 256); rr[ci][T][1] = *(const u32x2*)(rp + 264); }
                if (WB) { rb[ci][T][0] = *(const u32x2*)(rp + 128); rb[ci][T][1] = *(const u32x2*)(rp + 136); }
                if (WK) { rk[ci][T][0] = *(const u32x2*)(rp + 192); rk[ci][T][1] = *(const u32x2*)(rp + 200); } }
#pragma unroll
        for (int ci = 0; ci < 2; ++ci) { const int c = 2 * cp + ci;
            float carry[8];
#pragma unroll
            for (int j = 0; j < 8; ++j) carry[j] = 0.f;
#pragma unroll
            for (int T = 0; T < 2; ++T) {
                float d[8]; RW_UNP(d, rd[ci][T][0], rd[ci][T][1])
                float ei[8], ex[8], ev[8];
#pragma unroll
                for (int j = 0; j < 8; ++j) {
                    const float g = __logf(1.f - d[j]);
                    const float Bv = scan32(g) + carry[j];
                    const float tot = __shfl(Bv, (lane & 32) | 31);
                    if (T == 0) carry[j] = tot; else if (wbend && r32 == 0) bend[c * 8 + j] = tot;
                    ei[j] = __expf(Bv); ex[j] = __expf(Bv - g); ev[j] = __expf(fminf(-Bv, 80.f));
                }
                if (WA) { float f[8]; RW_UNP(f, ra[ci][T][0], ra[ci][T][1])
#pragma unroll
                    for (int j = 0; j < 8; ++j) f[j] *= ex[j];
                    RW_PK(At[T][c], f) }
                if (WR) { float f[8]; RW_UNP(f, rr[ci][T][0], rr[ci][T][1])
#pragma unroll
                    for (int j = 0; j < 8; ++j) f[j] *= ei[j];
                    RW_PK(Rt[T][c], f) }
                if (WB) { float f[8]; RW_UNP(f, rb[ci][T][0], rb[ci][T][1])
#pragma unroll
                    for (int j = 0; j < 8; ++j) f[j] *= ev[j];
                    RW_PK(Bb[T][c], f) }
                if (WK) { float f[8]; RW_UNP(f, rk[ci][T][0], rk[ci][T][1])
#pragma unroll
                    for (int j = 0; j < 8; ++j) f[j] *= ev[j];
                    RW_PK(Kb[T][c], f) }
            }
        }
        __builtin_amdgcn_sched_barrier(0);
    }
#undef RW_UNP
#undef RW_PK
}
__device__ __forceinline__ void rw_image(LAS unsigned char* img, const bf16x8 (&X)[2][4], int r32, int hi) {
#pragma unroll
    for (int T = 0; T < 2; ++T)
#pragma unroll
        for (int c = 0; c < 4; ++c) { const int k0 = 32 * (c >> 1) + 16 * (c & 1) + 4 * hi; const u32x4 v = __builtin_bit_cast(u32x4, X[T][c]);
            LAS unsigned char* w = img + (c >> 1) * 4096 + (32 * T + r32) * 64 + (k0 & 31) * 2;
            *(LAS u32x2*)w = (u32x2){v.x, v.y}; *(LAS u32x2*)(w + 16) = (u32x2){v.z, v.w}; }
}
#define RW_PACKH(dst, acc, o) { u32x4 p_; p_.x = pk2(acc[o], acc[o + 1]); p_.y = pk2(acc[o + 2], acc[o + 3]); p_.z = pk2(acc[o + 4], acc[o + 5]); p_.w = pk2(acc[o + 6], acc[o + 7]); dst = __builtin_bit_cast(bf16x8, p_); }
#define RW_VTR(base, dh, blk) ({ const s16x4 lo_ = att::vtr((base) + (dh) * 4096 + (blk) * 1024), hi_ = att::vtr((base) + (dh) * 4096 + (blk) * 1024 + 512); (bf16x8){lo_[0], lo_[1], lo_[2], lo_[3], hi_[0], hi_[1], hi_[2], hi_[3]}; })
#ifndef RWC_STAGE
#define RWC_STAGE 4
#endif
__device__ __forceinline__ void rwkv_chunk(Frame& F, const Args& A, int l, int b, int h, int seg) {
    int lane_ = lane_id(); asm volatile("" : "+v"(lane_));
    const int lane = lane_, ts = seg * 64; int r32 = lane & 31, hi = lane >> 5;
    const bf16* recb = (const bf16*)(F.ws + WS_SC + SC_RWS) + (size_t)((b * 4 + h) * SEQ + ts) * 320;
    const size_t mrow = (size_t)b * SEQ + ts;
    bf16* PRr = (bf16*)(F.ws + WS_PR) + mrow * PINP + SD0 + h * 64;
    LAS unsigned char* buf0 = F.lds + RING_OFF + F.wave * 16384;
    LAS unsigned char* buf1 = buf0 + 8192;
    LAS float* Al = (LAS float*)buf0;
    LAS float* bend = (LAS float*)(F.lds + MISC_OFF + 1024 + F.wave * 512) + hi * 32 + 64;
    att::lds_cptr rd0 = (att::lds_cptr)buf0 + ((lane >> 4) & 1) * 32 + (lane & 3) * 8 + (4 * hi + ((lane & 15) >> 2)) * 64;
    att::lds_cptr rd1 = rd0 + 8192;
#define RW_FENCE() do { __builtin_amdgcn_sched_barrier(0); int lq_ = lane; asm volatile("" : "+v"(lq_)); r32 = lq_ & 31; hi = lq_ >> 5; \
        bend = (LAS float*)(F.lds + MISC_OFF + 1024 + F.wave * 512) + hi * 32 + 64; \
        rd0 = (att::lds_cptr)buf0 + ((lq_ >> 4) & 1) * 32 + (lq_ & 3) * 8 + (4 * hi + ((lq_ & 15) >> 2)) * 64; rd1 = rd0 + 8192; } while (0)
    bf16x8 At[2][4], Rt[2][4], Bb[2][4], Kb[2][4];
    { int z_ = 0; asm volatile("" : "+s"(z_)); rw_ops<true, false, true, true>(recb + z_, r32, hi, lane, At, Rt, Bb, Kb, bend, true); }
    RW_FENCE();
#pragma unroll
    for (int tT = 0; tT < 2; ++tT)
#pragma unroll
        for (int sT = 0; sT < 2; ++sT) {
            f32x16 acc = f32x16{};
            if (sT <= tT) {
#pragma unroll
                for (int c = 0; c < 4; ++c) acc = __builtin_amdgcn_mfma_f32_32x32x16_bf16(At[tT][c], Bb[sT][c], acc, 0, 0, 0);
            }
#pragma unroll
            for (int r = 0; r < 16; ++r) { const int t = 32 * tT + crow32(r, hi), s = 32 * sT + r32; Al[t * 64 + s] = (s < t) ? acc[r] : 0.f; }
        }
    RW_FENCE();
    bf16x8 akp[3][2];
#pragma unroll
    for (int ti = 0; ti < 3; ++ti) { const int sT = ti >> 1, tT = (ti + 1) >> 1;
        f32x16 acc = f32x16{};
#pragma unroll
        for (int c = 0; c < 4; ++c) acc = __builtin_amdgcn_mfma_f32_32x32x16_bf16(Kb[sT][c], At[tT][c], acc, 0, 0, 0);
#pragma unroll
        for (int r = 0; r < 16; ++r) if (32 * sT + crow32(r, hi) >= 32 * tT + r32) acc[r] = 0.f;
        RW_PACKH(akp[ti][0], acc, 0) RW_PACKH(akp[ti][1], acc, 8) }
    v4u vcur[8];
    { const bf16* vp = PRr + 512 + (size_t)(lane >> 3) * PINP + (lane & 7) * 8;
#pragma unroll
      for (int i = 0; i < 8; ++i) { vcur[i] = *(const v4u*)vp; vp += 8 * PINP; } }
    RW_FENCE();
    float x[64];
#pragma unroll
    for (int s = 0; s < 64; ++s) x[s] = (s == lane) ? 1.f : 0.f;
#pragma unroll
    for (int sp = 63; sp >= 1; --sp) {
#pragma unroll
        for (int g4 = 0; g4 * 4 < sp; ++g4) { const f32x4 a4 = *(const LAS f32x4*)(Al + sp * 64 + 4 * g4);
#define FMAC1(acc, a, b) asm("v_fmac_f32 %0, %1, %2" : "+v"(acc) : "v"(a), "v"(b))
            FMAC1(x[4 * g4], x[sp], a4.x); if (4 * g4 + 1 < sp) FMAC1(x[4 * g4 + 1], x[sp], a4.y); if (4 * g4 + 2 < sp) FMAC1(x[4 * g4 + 2], x[sp], a4.z); if (4 * g4 + 3 < sp) FMAC1(x[4 * g4 + 3], x[sp], a4.w); }
        if ((sp & 3) == 0) __builtin_amdgcn_sched_barrier(0);
    }
    RW_FENCE();
    float TT[3][16];
#pragma unroll
    for (int sT = 0; sT < 2; ++sT)
#pragma unroll
        for (int r = 0; r < 16; ++r) { const int rho = 32 * sT + (r & 3) + 8 * (r >> 2);
            auto sw = __builtin_amdgcn_permlane32_swap(__float_as_uint(x[rho]), __float_as_uint(x[rho + 4]), false, false);
            if (sT == 0) { TT[0][r] = __uint_as_float(sw[0]); TT[1][r] = __uint_as_float(sw[1]); } else TT[2][r] = __uint_as_float(sw[1]); }
    bf16x8 Wpk[2][2][2], Tpk[3][2];
    RW_FENCE();
    rw_image(buf1, At, r32, hi);
#pragma unroll
    for (int ti = 0; ti < 3; ++ti) { RW_PACKH(Tpk[ti][0], TT[ti], 0) RW_PACKH(Tpk[ti][1], TT[ti], 8) }
#pragma unroll
    for (int tT = 0; tT < 2; ++tT)
#pragma unroll
        for (int kt = 0; kt < 2; ++kt) { f32x16 acc = f32x16{};
#pragma unroll
            for (int sT = 0; sT <= tT; ++sT) { const int ti = (tT == 0) ? 0 : 1 + sT;
#pragma unroll
                for (int hf = 0; hf < 2; ++hf) acc = __builtin_amdgcn_mfma_f32_32x32x16_bf16(Tpk[ti][hf], RW_VTR(rd1, kt, 2 * sT + hf), acc, 0, 0, 0); }
            RW_PACKH(Wpk[tT][kt][0], acc, 0) RW_PACKH(Wpk[tT][kt][1], acc, 8) }
#define RW_PARK(slot) ((u32x4*)((unsigned char*)F.out + 192 * MiB) + (size_t)(F.wave * F.G + (int)blockIdx.x) * 1536 + (slot) * 512 + (r32 + 32 * hi))
    u32x4* wpark = RW_PARK(0);
#pragma unroll
    for (int tT = 0; tT < 2; ++tT)
#pragma unroll
        for (int kt = 0; kt < 2; ++kt)
#pragma unroll
            for (int hf = 0; hf < 2; ++hf) wpark[((tT * 2 + kt) * 2 + hf) * 64] = __builtin_bit_cast(u32x4, Wpk[tT][kt][hf]);
    RW_FENCE();
    { const int cn = lane & 7, s0 = lane >> 3; const bf16* vp = PRr + 512 + (size_t)s0 * PINP + cn * 8; LAS unsigned char* vw = buf0 + (cn >> 2) * 4096 + s0 * 64 + (cn & 3) * 16;
      float mu8[8];
#pragma unroll
      for (int e = 0; e < 8; ++e) mu8[e] = A.in[15][l * 896 + 512 + h * 64 + cn * 8 + e];
      v4u vprv[8];
#pragma unroll
      for (int i = 0; i < 8; ++i) { const bool has = (ts + s0 + 8 * i) > 0; vprv[i] = *(const v4u*)(vp - (has ? PINP : 0)); vp += 8 * PINP; }
#pragma unroll
      for (int i = 0; i < 8; ++i) { const bool has = (ts + s0 + 8 * i) > 0;
          float fc[8], fp[8]; unpack8(vcur[i], fc); unpack8(vprv[i], fp);
          v4u o;
#pragma unroll
          for (int e = 0; e < 4; ++e) { const float p0 = has ? fp[2 * e] : 0.f, p1 = has ? fp[2 * e + 1] : 0.f; o[e] = pk2(fc[2 * e] + mu8[2 * e] * (p0 - fc[2 * e]), fc[2 * e + 1] + mu8[2 * e + 1] * (p1 - fc[2 * e + 1])); }
          *(LAS v4u*)(vw + i * 512) = o; } }
    RW_FENCE();
    bf16x8 Upk[2][2][2];
#pragma unroll
    for (int vt = 0; vt < 2; ++vt) {
        f32x16 X[2];
#pragma unroll
        for (int tT = 0; tT < 2; ++tT) { f32x16 acc = f32x16{};
#pragma unroll
            for (int sT = 0; sT <= tT; ++sT) { const int ti = sT + tT;
#pragma unroll
                for (int hf = 0; hf < 2; ++hf) acc = __builtin_amdgcn_mfma_f32_32x32x16_bf16(akp[ti][hf], RW_VTR(rd0, vt, 2 * sT + hf), acc, 0, 0, 0); }
            X[tT] = acc; }
#pragma unroll
        for (int tT = 0; tT < 2; ++tT) { f32x16 acc = f32x16{};
#pragma unroll
            for (int sT = 0; sT <= tT; ++sT) { const int ti = (tT == 0) ? 0 : 1 + sT;
#pragma unroll
                for (int r = 0; r < 16; ++r) acc = __builtin_amdgcn_mfma_f32_32x32x2f32(TT[ti][r], X[sT][r], acc, 0, 0, 0); }
            RW_PACKH(Upk[tT][vt][0], acc, 0) RW_PACKH(Upk[tT][vt][1], acc, 8) }
        __builtin_amdgcn_sched_barrier(0);
    }
    { u32x4* up = RW_PARK(1);
#pragma unroll
      for (int tT = 0; tT < 2; ++tT)
#pragma unroll
          for (int vt = 0; vt < 2; ++vt)
#pragma unroll
              for (int hf = 0; hf < 2; ++hf) up[((tT * 2 + vt) * 2 + hf) * 64] = __builtin_bit_cast(u32x4, Upk[tT][vt][hf]); }
    RW_FENCE();
    { int z_ = 0; asm volatile("" : "+s"(z_)); rw_ops<false, true, true, true>(recb + z_, r32, hi, lane, At, Rt, Bb, Kb, bend, false); }
    RW_FENCE();
    bf16x8 arp[3][2], akr[3][2];
#pragma unroll
    for (int ti = 0; ti < 3; ++ti) { const int sT = ti >> 1, tT = (ti + 1) >> 1;
        f32x16 a1 = f32x16{}, a2 = f32x16{};
#pragma unroll
        for (int c = 0; c < 4; ++c) { a1 = __builtin_amdgcn_mfma_f32_32x32x16_bf16(Bb[sT][c], Rt[tT][c], a1, 0, 0, 0); a2 = __builtin_amdgcn_mfma_f32_32x32x16_bf16(Kb[sT][c], Rt[tT][c], a2, 0, 0, 0); }
#pragma unroll
        for (int r = 0; r < 16; ++r) if (32 * sT + crow32(r, hi) > 32 * tT + r32) { a1[r] = 0.f; a2[r] = 0.f; }
        RW_PACKH(arp[ti][0], a1, 0) RW_PACKH(arp[ti][1], a1, 8) RW_PACKH(akr[ti][0], a2, 0) RW_PACKH(akr[ti][1], a2, 8) }
    { u32x4* rp_ = RW_PARK(2);
#pragma unroll
      for (int T = 0; T < 2; ++T)
#pragma unroll
          for (int c = 0; c < 4; ++c) rp_[(T * 4 + c) * 64] = __builtin_bit_cast(u32x4, Rt[T][c]); }
    RW_FENCE();
    { int z_ = 0; asm volatile("" : "+s"(z_)); const u32x4* up = RW_PARK(1) + z_;
#pragma unroll
      for (int tT = 0; tT < 2; ++tT)
#pragma unroll
          for (int vt = 0; vt < 2; ++vt)
#pragma unroll
              for (int hf = 0; hf < 2; ++hf) Upk[tT][vt][hf] = __builtin_bit_cast(bf16x8, up[((tT * 2 + vt) * 2 + hf) * 64]); }
#pragma unroll
    for (int tT = 0; tT < 2; ++tT) { f32x16 Y[2]; Y[0] = f32x16{}; Y[1] = f32x16{};
#pragma unroll
        for (int sT = 0; sT <= tT; ++sT) { const int ti = sT + tT;
#pragma unroll
            for (int hf = 0; hf < 2; ++hf)
#pragma unroll
                for (int vt = 0; vt < 2; ++vt) { Y[vt] = __builtin_amdgcn_mfma_f32_32x32x16_bf16(arp[ti][hf], Upk[sT][vt][hf], Y[vt], 0, 0, 0);
                    Y[vt] = __builtin_amdgcn_mfma_f32_32x32x16_bf16(akr[ti][hf], RW_VTR(rd0, vt, 2 * sT + hf), Y[vt], 0, 0, 0); } }
        { const int yo = (32 * tT + 4 * hi) * PINP + r32;
#pragma unroll
          for (int r = 0; r < 16; ++r) { const int ro = yo + ((r & 3) + 8 * (r >> 2)) * PINP; PRr[ro] = (bf16)f2bf(Y[0][r]); PRr[ro + 32] = (bf16)f2bf(Y[1][r]); } } }
    const size_t item = (size_t)((b * 4 + h) * NSR + seg);
#if RWC_STAGE >= 2
    RW_FENCE();
    { f32x16 Sl[2][2];
      rw_image(buf1, Bb, r32, hi);
#pragma unroll
      for (int kt = 0; kt < 2; ++kt)
#pragma unroll
          for (int vt = 0; vt < 2; ++vt) { f32x16 acc = f32x16{};
#pragma unroll
              for (int blk = 0; blk < 4; ++blk) acc = __builtin_amdgcn_mfma_f32_32x32x16_bf16(RW_VTR(rd1, kt, blk), Upk[blk >> 1][vt][blk & 1], acc, 0, 0, 0);
              Sl[kt][vt] = acc; }
      rw_image(buf1, Kb, r32, hi);
#pragma unroll
      for (int kt = 0; kt < 2; ++kt)
#pragma unroll
          for (int vt = 0; vt < 2; ++vt) { f32x16 acc = Sl[kt][vt];
#pragma unroll
              for (int blk = 0; blk < 4; ++blk) acc = __builtin_amdgcn_mfma_f32_32x32x16_bf16(RW_VTR(rd1, kt, blk), RW_VTR(rd0, vt, blk), acc, 0, 0, 0);
              u32x4* so = (u32x4*)((unsigned char*)F.out + CRW_S) + item * 512 + ((kt * 2 + vt) * 64 + (r32 + 32 * hi)) * 2;
#pragma unroll
              for (int q = 0; q < 2; ++q) { u32x4 v4;
#pragma unroll
                  for (int e = 0; e < 4; ++e) { const int r = 8 * q + 2 * e;
                      v4[e] = pk2(acc[r] * __expf(bend[(2 * kt + (r >> 3)) * 8 + (r & 7)]), acc[r + 1] * __expf(bend[(2 * kt + ((r + 1) >> 3)) * 8 + ((r + 1) & 7)])); }
                  so[q] = v4; } } }
#endif
#if RWC_STAGE >= 3
    RW_FENCE();
    { int z_ = 0; asm volatile("" : "+s"(z_)); const u32x4* wp2 = RW_PARK(0) + z_;
#pragma unroll
      for (int tT = 0; tT < 2; ++tT)
#pragma unroll
          for (int kt = 0; kt < 2; ++kt)
#pragma unroll
              for (int hf = 0; hf < 2; ++hf) Wpk[tT][kt][hf] = __builtin_bit_cast(bf16x8, wp2[((tT * 2 + kt) * 2 + hf) * 64]); }
    { int z_ = 0; asm volatile("" : "+s"(z_)); const u32x4* rp_ = RW_PARK(2) + z_;
#pragma unroll
      for (int T = 0; T < 2; ++T)
#pragma unroll
          for (int c = 0; c < 4; ++c) Rt[T][c] = __builtin_bit_cast(bf16x8, rp_[(T * 4 + c) * 64]); }
    rw_image(buf1, Rt, r32, hi);
    bf16x8 Ipk[2];
    { float f0[8], f1[8];
#pragma unroll
      for (int j = 0; j < 8; ++j) { f0[j] = (crow32(j, hi) == r32) ? 1.f : 0.f; f1[j] = (crow32(j + 8, hi) == r32) ? 1.f : 0.f; }
      RW_PACKH(Ipk[0], f0, 0) RW_PACKH(Ipk[1], f1, 0) }
#pragma unroll
    for (int tT = 0; tT < 2; ++tT) { f32x16 Z[2]; Z[0] = f32x16{}; Z[1] = f32x16{};
#pragma unroll
        for (int kt = 0; kt < 2; ++kt) {
#pragma unroll
            for (int sT = 0; sT <= tT; ++sT) { const int ti = sT + tT;
#pragma unroll
                for (int hf = 0; hf < 2; ++hf) Z[kt] = __builtin_amdgcn_mfma_f32_32x32x16_bf16(arp[ti][hf], Wpk[sT][kt][hf], Z[kt], 0, 0, 0); }
#pragma unroll
            for (int hf = 0; hf < 2; ++hf) Z[kt] = __builtin_amdgcn_mfma_f32_32x32x16_bf16(Ipk[hf], RW_VTR(rd1, kt, 2 * tT + hf), Z[kt], 0, 0, 0); }
        { const int zo = 256 + (32 * tT + 4 * hi) * PINP + r32;
#pragma unroll
          for (int r = 0; r < 16; ++r) { const int ro = zo + ((r & 3) + 8 * (r >> 2)) * PINP; PRr[ro] = (bf16)f2bf(Z[0][r]); PRr[ro + 32] = (bf16)f2bf(Z[1][r]); } } }
#endif
#if RWC_STAGE >= 4
    RW_FENCE();
    rw_image(buf1, Bb, r32, hi);
    { bf16* po = (bf16*)((unsigned char*)F.out + CRW_P) + item * 4096;
#pragma unroll
      for (int kt = 0; kt < 2; ++kt)
#pragma unroll
          for (int k2 = 0; k2 < 2; ++k2) { f32x16 acc = f32x16{};
#pragma unroll
              for (int blk = 0; blk < 4; ++blk) acc = __builtin_amdgcn_mfma_f32_32x32x16_bf16(RW_VTR(rd1, kt, blk), Wpk[blk >> 1][k2][blk & 1], acc, 0, 0, 0);
              const int po_ = (32 * kt + 4 * hi) * 64 + 32 * k2 + r32, dg = (kt == k2) ? r32 - 4 * hi : -1;
#pragma unroll
              for (int r = 0; r < 16; ++r) po[po_ + ((r & 3) + 8 * (r >> 2)) * 64] = (bf16)f2bf((acc[r] + (((r & 3) + 8 * (r >> 2)) == dg ? 1.f : 0.f)) * __expf(bend[(2 * kt + (r >> 3)) * 8 + (r & 7)])); } }
#endif
#undef RW_FENCE
#undef RW_PARK
}
__device__ __forceinline__ void scan_phase(Frame& F, const Args& A, int l) {
    const int gw = F.wave * F.G + (int)blockIdx.x;
    const int NGW = NWAVES * F.G;
    for (int it = gw; it < 32 * (NSR + NSH + NSG); it += NGW) {
        if (it < 32 * NSR) { const int sh = it / NSR;
#if RWC_STAGE < 4
            scan_rwkv(F, A, l, sh >> 2, sh & 3, it % NSR);
#endif
            rwkv_chunk(F, A, l, sh >> 2, sh & 3, it % NSR); }
        else if (it < 32 * (NSR + NSH)) { const int i2 = it - 32 * NSR, sh = i2 / NSH; chunk_scan<64, false>(F, sh >> 2, sh & 3, i2 % NSH); }
        else { const int i2 = it - 32 * (NSR + NSH), sh = i2 / NSG; chunk_scan<32, true>(F, sh >> 2, sh & 3, i2 % NSG); }
    }
}
__device__ __forceinline__ void carry_phase(Frame& F) {
    const int blk = (int)blockIdx.x, w = F.wave, lane = F.lane, r32 = lane & 31, hi = lane >> 5;
    unsigned char* X2b = (unsigned char*)F.out;
    if (blk < 32) {
        const int sh = blk, i = (w >> 1) & 1, jv = w & 1;
        LAS unsigned char* Sb = F.lds + RING_OFF;
        LAS unsigned char* Ab = Sb + 2 * 9216;
        for (int idx = F.tid; idx < 2 * 64 * 144 / 4; idx += NWAVES * 64) ((LAS unsigned*)Sb)[idx] = 0u;
        bf16* ST = (bf16*)(X2b + CRW_T) + (size_t)sh * NSR * 4096;
        constexpr int CPD = 16;
        static_assert(NSR % CPD == 0, "chain length");
        if (w < 4) {
            const v4u* SL4 = (const v4u*)(X2b + CRW_S) + (size_t)sh * NSR * 512 + ((i * 2 + jv) * 64 + lane) * 2;
            v4u aq[CPD][2];
#define CY_LOAD(u, jj) do { const int jn_ = ((jj) < NSR - 1) ? (jj) : NSR - 2; \
            _Pragma("unroll") for (int q = 0; q < 2; ++q) aq[u][q] = SL4[(size_t)jn_ * 512 + q]; } while (0)
#pragma unroll
            for (int u = 0; u < CPD; ++u) CY_LOAD(u, u);
            asm volatile("s_waitcnt lgkmcnt(0)\n\ts_barrier" ::: "memory");
            for (int j0 = 0; j0 < NSR; j0 += CPD) {
#pragma unroll
                for (int u = 0; u < CPD; ++u) { const int j = j0 + u;
                    LAS unsigned char* Sr = Sb + (u & 1) * 9216; LAS unsigned char* Sw = Sb + ((u + 1) & 1) * 9216; LAS unsigned char* Ar = Ab + (u & 1) * 9216;
                    f32x16 acc;
#pragma unroll
                    for (int q = 0; q < 2; ++q) { const unsigned d0 = aq[u][q].x, d1 = aq[u][q].y, d2 = aq[u][q].z, d3 = aq[u][q].w;
                        acc[8 * q] = __builtin_bit_cast(float, d0 << 16); acc[8 * q + 1] = __builtin_bit_cast(float, d0 & 0xffff0000u); acc[8 * q + 2] = __builtin_bit_cast(float, d1 << 16); acc[8 * q + 3] = __builtin_bit_cast(float, d1 & 0xffff0000u);
                        acc[8 * q + 4] = __builtin_bit_cast(float, d2 << 16); acc[8 * q + 5] = __builtin_bit_cast(float, d2 & 0xffff0000u); acc[8 * q + 6] = __builtin_bit_cast(float, d3 << 16); acc[8 * q + 7] = __builtin_bit_cast(float, d3 & 0xffff0000u); }
#pragma unroll
                    for (int kk = 0; kk < 4; ++kk) {
                        const bf16x8 afr = *(const LAS bf16x8*)(Ar + (32 * i + r32) * 144 + (16 * kk + 8 * hi) * 2);
                        const bf16x8 bfr = *(const LAS bf16x8*)(Sr + (32 * jv + r32) * 144 + (16 * kk + 8 * hi) * 2);
                        acc = __builtin_amdgcn_mfma_f32_32x32x16_bf16(afr, bfr, acc, 0, 0, 0);
                    }
                    CY_LOAD(u, j + CPD);
#pragma unroll
                    for (int q = 0; q < 4; ++q) { const int k = 32 * i + 8 * q + 4 * hi;
                        *(LAS unsigned long long*)(Sw + (32 * jv + r32) * 144 + k * 2) = (unsigned long long)pk2(acc[4 * q], acc[4 * q + 1]) | ((unsigned long long)pk2(acc[4 * q + 2], acc[4 * q + 3]) << 32); }
                    asm volatile("s_waitcnt lgkmcnt(0)\n\ts_barrier" ::: "memory");
                }
            }
#undef CY_LOAD
        } else {
            const int t = (w - 4) * 64 + lane, row = t >> 2, ch = t & 3;
            const v4u* PTg = (const v4u*)((const bf16*)(X2b + CRW_P) + (size_t)sh * NSR * 4096 + row * 64 + ch * 16);
            v4u pq[CPD][2];
#define CP_LOAD(u, jj) do { const int jn_ = ((jj) < NSR - 1) ? (jj) : NSR - 2; pq[u][0] = PTg[(size_t)jn_ * 512]; pq[u][1] = PTg[(size_t)jn_ * 512 + 1]; } while (0)
#pragma unroll
            for (int u = 0; u < CPD; ++u) CP_LOAD(u, u);
            { LAS unsigned char* Aw = Ab + row * 144 + ch * 32; *(LAS v4u*)Aw = pq[0][0]; *(LAS v4u*)(Aw + 16) = pq[0][1]; }
            CP_LOAD(0, CPD);
            asm volatile("s_waitcnt lgkmcnt(0)\n\ts_barrier" ::: "memory");
            for (int j0 = 0; j0 < NSR; j0 += CPD) {
#pragma unroll
                for (int u = 0; u < CPD; ++u) { const int j = j0 + u; constexpr int dmy_ = 0; (void)dmy_;
                    { LAS unsigned char* Aw = Ab + ((u + 1) & 1) * 9216 + row * 144 + ch * 32;
                      *(LAS v4u*)Aw = pq[(u + 1) % CPD][0]; *(LAS v4u*)(Aw + 16) = pq[(u + 1) % CPD][1]; }
                    CP_LOAD((u + 1) % CPD, j + 1 + CPD);
                    asm volatile("s_waitcnt lgkmcnt(0)\n\ts_barrier" ::: "memory");
                    const LAS unsigned char* Sw = Sb + ((u + 1) & 1) * 9216 + row * 144 + ch * 32;
                    const v4u x0 = *(const LAS v4u*)Sw, x1 = *(const LAS v4u*)(Sw + 16);
                    const int jst = (j + 1) & (NSR - 1);
                    v4u* dst = (v4u*)(ST + (size_t)jst * 4096 + row * 64 + ch * 16);
                    dst[0] = x0; dst[1] = x1; }
            }
#undef CP_LOAD
        }
    } else if (blk < 64) {
        const int sh = blk - 32;
        float s[8];
#pragma unroll
        for (int e = 0; e < 8; ++e) s[e] = 0.f;
        const float* SL = (const float*)(X2b + CH_S) + (size_t)sh * NSH * 4096 + (8 * w) * 64 + lane; const float* GG = (const float*)(X2b + CH_G) + (size_t)sh * NSH * 64 + 8 * w;
        bf16* ST = (bf16*)(X2b + CH_T) + (size_t)sh * NSH * 4096 + lane * 64 + 8 * w;
        for (int j0 = 0; j0 < NSH; j0 += 8) {
            float gq[8][8], lq[8][8]; v4u o[8];
#pragma unroll
            for (int u = 0; u < 8; ++u) { const int jn = (j0 + u < NSH - 1) ? j0 + u : NSH - 2;
#pragma unroll
                for (int e = 0; e < 8; ++e) { gq[u][e] = GG[jn * 64 + e]; lq[u][e] = SL[(size_t)jn * 4096 + e * 64]; } }
#pragma unroll
            for (int u = 0; u < 8; ++u) {
#pragma unroll
                for (int e = 0; e < 8; ++e) s[e] = gq[u][e] * s[e] + lq[u][e];
                o[u].x = pk2(s[0], s[1]); o[u].y = pk2(s[2], s[3]); o[u].z = pk2(s[4], s[5]); o[u].w = pk2(s[6], s[7]); }
#pragma unroll
            for (int u = 0; u < 8; ++u) *(v4u*)(ST + (size_t)((j0 + u + 1) & (NSH - 1)) * 4096) = o[u];
        }
    } else if (blk < 96) {
        const int sh = blk - 64;
        float s[4];
#pragma unroll
        for (int e = 0; e < 4; ++e) s[e] = 0.f;
        const float* SL = (const float*)(X2b + CG_S) + (size_t)sh * NSG * 2048 + (4 * w) * 64 + lane; const float* GG = (const float*)(X2b + CG_G) + (size_t)sh * NSG * 32 + 4 * w;
        bf16* ST = (bf16*)(X2b + CG_T) + (size_t)sh * NSG * 2048 + lane * 32 + 4 * w;
        for (int j0 = 0; j0 < NSG; j0 += 8) {
            float gq[8][4], lq[8][4]; unsigned long long o[8];
#pragma unroll
            for (int u = 0; u < 8; ++u) { const int jn = (j0 + u < NSG - 1) ? j0 + u : NSG - 2;
#pragma unroll
                for (int e = 0; e < 4; ++e) { gq[u][e] = GG[jn * 32 + e]; lq[u][e] = SL[(size_t)jn * 2048 + e * 64]; } }
#pragma unroll
            for (int u = 0; u < 8; ++u) {
#pragma unroll
                for (int e = 0; e < 4; ++e) s[e] = gq[u][e] * s[e] + lq[u][e];
                o[u] = (unsigned long long)pk2(s[0], s[1]) | ((unsigned long long)pk2(s[2], s[3]) << 32); }
#pragma unroll
            for (int u = 0; u < 8; ++u) *(unsigned long long*)(ST + (size_t)((j0 + u + 1) & (NSG - 1)) * 2048) = o[u];
        }
    }
}
template <int K> __device__ __forceinline__ void fix_tile(const bf16* z, int zpitch, bf16* y, const bf16* ST, int lane) {
    const int r32 = lane & 31, hi = lane >> 5;
    bf16x8 a[K / 16];
#pragma unroll
    for (int kk = 0; kk < K / 16; ++kk) a[kk] = *(const bf16x8*)(z + (size_t)r32 * zpitch + 16 * kk + 8 * hi);
#pragma unroll
    for (int jv = 0; jv < 2; ++jv) {
        f32x16 acc;
#pragma unroll
        for (int r = 0; r < 16; ++r) acc[r] = bf2f(y[(size_t)att::crow(r, hi) * PINP + 32 * jv + r32]);
#pragma unroll
        for (int kk = 0; kk < K / 16; ++kk) { const bf16x8 bb = *(const bf16x8*)(ST + (32 * jv + r32) * K + 16 * kk + 8 * hi); acc = __builtin_amdgcn_mfma_f32_32x32x16_bf16(a[kk], bb, acc, 0, 0, 0); }
#pragma unroll
        for (int r = 0; r < 16; ++r) y[(size_t)att::crow(r, hi) * PINP + 32 * jv + r32] = (bf16)f2bf(acc[r]);
    }
}
__device__ __forceinline__ void fixup_phase(Frame& F) {
    const int gw = F.vcu * NWAVES + F.wave, NGW = F.G * NWAVES, lane = F.lane;
    unsigned char* X2b = (unsigned char*)F.out;
    constexpr int PR_R = (NSR - 1) * (LR / 32), PR_H = (NSH - 1) * (LH / 32), PR_G = (NSG - 1) * (LG / 32);
    constexpr int NI_R = 32 * PR_R, NI_H = 32 * PR_H, NI_G = 32 * PR_G;
    for (int it = gw; it < NI_R + NI_H + NI_G; it += NGW) {
        if (it < NI_R) { const int sh = it / PR_R, rem = it % PR_R, seg = 1 + rem / (LR / 32), tt = rem % (LR / 32);
            const size_t m0 = (size_t)(sh >> 2) * SEQ + seg * LR + tt * 32; const int h = sh & 3;
            fix_tile<64>(((bf16*)(F.ws + WS_PR)) + m0 * PINP + SD0 + 256 + h * 64, PINP, ((bf16*)(F.ws + WS_PR)) + m0 * PINP + SD0 + h * 64, (const bf16*)(X2b + CRW_T) + (size_t)(sh * NSR + seg) * 4096, lane); }
        else if (it < NI_R + NI_H) { const int i2 = it - NI_R, sh = i2 / PR_H, rem = i2 % PR_H, seg = 1 + rem / (LH / 32), tt = rem % (LH / 32);
            const size_t m0 = (size_t)(sh >> 2) * SEQ + seg * LH + tt * 32; const int h = sh & 3;
            fix_tile<64>(((bf16*)(F.ws + WS_PR)) + m0 * PINP + SC0 + 256 + h * 64, PINP, ((bf16*)(F.ws + WS_PR)) + m0 * PINP + SC0 + h * 64, (const bf16*)(X2b + CH_T) + (size_t)(sh * NSH + seg) * 4096, lane); }
        else { const int i2 = it - NI_R - NI_H, sh = i2 / PR_G, rem = i2 % PR_G, seg = 1 + rem / (LG / 32), tt = rem % (LG / 32);
            const size_t m0 = (size_t)(sh >> 2) * SEQ + seg * LG + tt * 32; const int h = sh & 3;
            fix_tile<32>(((bf16*)(F.ws + WS_ZG)) + m0 * 128 + h * 32, 128, ((bf16*)(F.ws + WS_PR)) + m0 * PINP + SB0 + h * 64, (const bf16*)(X2b + CG_T) + (size_t)(sh * NSG + seg) * 2048, lane); }
    }
}
__device__ __forceinline__ void finalize_phase(Frame& F, const Args& A, int l) {
    LAS unsigned char* sgb = F.lds + RING_OFF;
    LAS float* gl = (LAS float*)(F.lds + RING_OFF + 8192);
    LAS bf16* fixl = (LAS bf16*)(F.lds + RING_OFF + 8192 + 32768);
    unsigned char* CB = (unsigned char*)F.out;
    const int tid = F.tid, c = tid & 255, th = __builtin_amdgcn_readfirstlane(tid >> 8), h = __builtin_amdgcn_readfirstlane(c >> 6);
    const float* mu = A.in[15] + l * 896;
    const float gla_g = A.in[12][l * 64 + (c & 63)], hg_g = A.in[14][l * 64 + (c & 63)], lng = A.in[24][l * 256 + c], lnb = A.in[25][l * 256 + c], mu_v = mu[512 + c];
    const int r32 = F.lane & 31, hi = F.lane >> 5, wv = F.wave;
    bf16x8 bgu[4];
#pragma unroll
    for (int kk = 0; kk < 4; ++kk)
#pragma unroll
        for (int i = 0; i < 8; ++i) bgu[kk][i] = (short)f2bf(A.in[20][(l * 64 + 16 * kk + 8 * hi + i) * 256 + 32 * wv + r32]);
    const int mxA = wv >> 2, hhA = wv & 3;
    const int c4 = 4 * F.lane, hl = F.lane >> 4;
    const f32x4 glag4 = *(const f32x4*)(A.in[12] + l * 64 + (c4 & 63)), hgg4 = *(const f32x4*)(A.in[14] + l * 64 + (c4 & 63)), lng4 = *(const f32x4*)(A.in[24] + l * 256 + c4), lnb4 = *(const f32x4*)(A.in[25] + l * 256 + c4), muv4 = *(const f32x4*)(mu + 512 + c4);
    bf16 s1r[4], s1p[4];
    bf16x8 afA[4], b0A[4], b1A[4], afB[2], b0B[2], b1B[2];
    u32x2 i_oa[4], i_yb[4], i_ogb[4], i_yc[4], i_ogc[4], i_yd[4], i_vr[4], i_vp[4]; float i_bs[4];
#define FI_LOADT(k, M0) do { const int tok_ = 4 * wv + (k), t_ = (M0) % SEQ + tok_; const size_t m_ = (size_t)(M0) + tok_; const bf16* row = ((bf16*)(F.ws + WS_PR)) + m_ * PINP + c4; \
        i_oa[k] = *(const u32x2*)(row + SA0); i_yb[k] = *(const u32x2*)(row + SB0); i_ogb[k] = *(const u32x2*)(row + SB0 + 528); i_yc[k] = *(const u32x2*)(row + SC0); i_ogc[k] = *(const u32x2*)(row + SC0 + 768); \
        i_yd[k] = *(const u32x2*)(row + SD0); i_vr[k] = *(const u32x2*)(row + SD0 + 512); i_vp[k] = *(const u32x2*)(row + SD0 + 512 - (t_ > 0 ? PINP : 0)); i_bs[k] = ((float*)(F.ws + WS_BS))[m_ * 4 + hl]; } while (0)
#define FI_HEAD(M0) do { const int m0_ = (M0), t0_ = m0_ % SEQ, bq_ = m0_ / SEQ; \
        _Pragma("unroll") for (int e = 0; e < 4; ++e) { const int idx = tid * 4 + e, i = idx >> 6, j = idx & 63; const size_t m = (size_t)m0_ + i; \
            s1r[e] = ((bf16*)(F.ws + WS_PR))[m * PINP + SD0 + 832 + j]; s1p[e] = ((bf16*)(F.ws + WS_PR))[(m - (t0_ + i > 0 ? 1 : 0)) * PINP + SD0 + 832 + j]; } \
        { const int sh = bq_ * 4 + hhA; \
          const bf16* zp = ((bf16*)(F.ws + WS_PR)) + ((size_t)m0_ + r32) * PINP + (mxA == 0 ? SD0 : SC0) + 256 + hhA * 64; \
          const bf16* stp = (mxA == 0) ? (const bf16*)(CB + CRW_T) + (size_t)(sh * NSR + t0_ / LR) * 4096 : (const bf16*)(CB + CH_T) + (size_t)(sh * NSH + t0_ / LH) * 4096; \
          _Pragma("unroll") for (int kk = 0; kk < 4; ++kk) { afA[kk] = *(const bf16x8*)(zp + 16 * kk + 8 * hi); b0A[kk] = *(const bf16x8*)(stp + r32 * 64 + 16 * kk + 8 * hi); b1A[kk] = *(const bf16x8*)(stp + (32 + r32) * 64 + 16 * kk + 8 * hi); } \
        } } while (0)
#define BF4(v, o) do { o[0] = __builtin_bit_cast(float, (v).x << 16); o[1] = __builtin_bit_cast(float, (v).x & 0xffff0000u); o[2] = __builtin_bit_cast(float, (v).y << 16); o[3] = __builtin_bit_cast(float, (v).y & 0xffff0000u); } while (0)
#define ROW16(v) do { v += dppf<0xB1>(v); v += dppf<0x4E>(v); v += dppf<0x141>(v); v += dppf<0x140>(v); } while (0)
    if (F.vcu < M / 32) { FI_HEAD(F.vcu * 32);
#pragma unroll
        for (int k = 0; k < 4; ++k) FI_LOADT(k, F.vcu * 32); }
    for (int u = F.vcu; u < M / 32; u += F.G) {
        const int m0 = u * 32, t0 = m0 % SEQ;
#pragma unroll
        for (int e = 0; e < 4; ++e) { const int idx = tid * 4 + e, i = idx >> 6, j = idx & 63;
            const float raw = bf2f(s1r[e]); const float prev = (t0 + i > 0) ? bf2f(s1p[e]) : 0.f;
            *(LAS bf16*)(sgb + i * 144 + j * 2) = (bf16)f2bf(sigmoidf_(raw + mu[832 + j] * (prev - raw))); }
        const int segR = t0 / LR, segH = t0 / LH, segG = t0 / LG;
        { const bf16* zq = ((bf16*)(F.ws + WS_ZG)) + ((size_t)m0 + r32) * 128 + hhA * 32;
          const bf16* stq = (const bf16*)(CB + CG_T) + (size_t)((m0 / SEQ * 4 + hhA) * NSG + segG) * 2048;
#pragma unroll
          for (int kk = 0; kk < 2; ++kk) { afB[kk] = *(const bf16x8*)(zq + 16 * kk + 8 * hi); b0B[kk] = *(const bf16x8*)(stq + r32 * 32 + 16 * kk + 8 * hi); b1B[kk] = *(const bf16x8*)(stq + (32 + r32) * 32 + 16 * kk + 8 * hi); } }
        LDS_BAR();
        { f32x16 cgv = {};
#pragma unroll
          for (int kk = 0; kk < 4; ++kk) { const bf16x8 ag = *(const LAS bf16x8*)(sgb + r32 * 144 + (16 * kk + 8 * hi) * 2); cgv = __builtin_amdgcn_mfma_f32_32x32x16_bf16(ag, bgu[kk], cgv, 0, 0, 0); }
#pragma unroll
          for (int r = 0; r < 16; ++r) gl[att::crow(r, hi) * 256 + 32 * wv + r32] = cgv[r]; }
        if ((mxA == 0 ? segR : segH) > 0) {
            f32x16 c0 = {}, c1 = {};
#pragma unroll
            for (int kk = 0; kk < 4; ++kk) { c0 = __builtin_amdgcn_mfma_f32_32x32x16_bf16(afA[kk], b0A[kk], c0, 0, 0, 0); c1 = __builtin_amdgcn_mfma_f32_32x32x16_bf16(afA[kk], b1A[kk], c1, 0, 0, 0); }
            LAS bf16* fo = fixl + mxA * 8192 + hhA * 64 + r32;
#pragma unroll
            for (int r = 0; r < 16; ++r) { fo[att::crow(r, hi) * 256] = (bf16)f2bf(c0[r]); fo[att::crow(r, hi) * 256 + 32] = (bf16)f2bf(c1[r]); }
        }
        if (wv < 4 && segG > 0) {
            f32x16 c0 = {}, c1 = {};
#pragma unroll
            for (int kk = 0; kk < 2; ++kk) { c0 = __builtin_amdgcn_mfma_f32_32x32x16_bf16(afB[kk], b0B[kk], c0, 0, 0, 0); c1 = __builtin_amdgcn_mfma_f32_32x32x16_bf16(afB[kk], b1B[kk], c1, 0, 0, 0); }
            LAS bf16* fo = fixl + 2 * 8192 + hhA * 64 + r32;
#pragma unroll
            for (int r = 0; r < 16; ++r) { fo[att::crow(r, hi) * 256] = (bf16)f2bf(c0[r]); fo[att::crow(r, hi) * 256 + 32] = (bf16)f2bf(c1[r]); }
        }
        LDS_BAR();
        const int un = (u + F.G < M / 32) ? u + F.G : u;
        FI_HEAD(un * 32);
#pragma unroll
        for (int k = 0; k < 4; ++k) {
            const int tok = 4 * wv + k;
            float yb[4], ogb[4], yc[4], ogc[4], yd[4], vr[4], vp[4], fx[4];
            BF4(i_yb[k], yb); BF4(i_ogb[k], ogb); BF4(i_yc[k], yc); BF4(i_ogc[k], ogc); BF4(i_yd[k], yd); BF4(i_vr[k], vr); BF4(i_vp[k], vp);
            if (segG > 0) { const u32x2 f2 = *(const LAS u32x2*)(fixl + 2 * 8192 + tok * 256 + c4); BF4(f2, fx);
#pragma unroll
                for (int e = 0; e < 4; ++e) yb[e] += fx[e]; }
            if (segH > 0) { const u32x2 f2 = *(const LAS u32x2*)(fixl + 8192 + tok * 256 + c4); BF4(f2, fx);
#pragma unroll
                for (int e = 0; e < 4; ++e) yc[e] += fx[e]; }
            if (segR > 0) { const u32x2 f2 = *(const LAS u32x2*)(fixl + tok * 256 + c4); BF4(f2, fx);
#pragma unroll
                for (int e = 0; e < 4; ++e) yd[e] += fx[e]; }
            const f32x4 g4 = *(const LAS f32x4*)(gl + tok * 256 + c4);
            float sb = (yb[0] * yb[0] + yb[1] * yb[1]) + (yb[2] * yb[2] + yb[3] * yb[3]), sc = (yc[0] * yc[0] + yc[1] * yc[1]) + (yc[2] * yc[2] + yc[3] * yc[3]), sd = (yd[0] + yd[1]) + (yd[2] + yd[3]);
            ROW16(sb); ROW16(sc); ROW16(sd);
            const float rb = RS_EPS(sb, 1.f / 64.f, 64e-6f), rc = RS_EPS(sc, 1.f / 64.f, 64e-6f), mean = sd * (1.f / 64.f);
            float dy[4];
#pragma unroll
            for (int e = 0; e < 4; ++e) dy[e] = yd[e] - mean;
            float var = (dy[0] * dy[0] + dy[1] * dy[1]) + (dy[2] * dy[2] + dy[3] * dy[3]);
            ROW16(var);
            const float rd = RS_EPS(var, 1.f / 64.f, 64.f * 64e-5f);
            const bool t_pos = (t0 + tok > 0);
            float ob[4], oc[4], od[4];
#pragma unroll
            for (int e = 0; e < 4; ++e) {
                ob[e] = yb[e] * rb * glag4[e] * ogb[e] * sigmoidf_(ogb[e]);
                oc[e] = yc[e] * rc * hgg4[e] * ogc[e] * sigmoidf_(ogc[e]);
                const float yn = dy[e] * rd * lng4[e] + lnb4[e];
                const float vpv = t_pos ? vp[e] : 0.f;
                const float v = vr[e] + muv4[e] * (vpv - vr[e]);
                od[e] = (yn + i_bs[k] * v) * g4[e];
            }
            bf16* row = ((bf16*)(F.ws + WS_PR)) + ((size_t)m0 + tok) * PINP + SC0 + c4;
            u32x2 w;
            *(u32x2*)row = i_oa[k];
            w.x = pk2(ob[0], ob[1]); w.y = pk2(ob[2], ob[3]); *(u32x2*)(row + 256) = w;
            w.x = pk2(oc[0], oc[1]); w.y = pk2(oc[2], oc[3]); *(u32x2*)(row + 512) = w;
            w.x = pk2(od[0], od[1]); w.y = pk2(od[2], od[3]); *(u32x2*)(row + 768) = w;
            FI_LOADT(k, un * 32);
        }
        LDS_BAR();
    }
#undef FI_LOADT
#undef FI_HEAD
#undef BF4
#undef ROW16
}
__global__ void __launch_bounds__(NWAVES * 64, 2) fwd_kernel(Args args) {
    extern __shared__ __attribute__((aligned(16))) unsigned char lds[];
    Frame F;
    F.lds = (LAS unsigned char*)lds;
    F.MISC = (volatile LAS unsigned*)(F.lds + MISC_OFF);
    F.tid = threadIdx.x; F.lane = F.tid & 63; F.wave = __builtin_amdgcn_readfirstlane(F.tid >> 6);
    const int wave0_ = F.wave;
    F.G = gridDim.x; { const int bx = blockIdx.x; F.vcu = (F.G % 8 == 0) ? (bx % 8) * (F.G / 8) + bx / 8 : bx; }
    unsigned char* ws = args.ws; F.ws = ws; F.out = args.out;
    F.ctl = (gu32*)(ws + WS_CTL);
    for (int u = F.tid; u < (LDS_BYTES - LDSCTL_OFF) / 4; u += NWAVES * 64) ((LAS unsigned*)(F.lds + LDSCTL_OFF))[u] = 0u;
    __syncthreads();
    XcdBarrier bar = xcd_barrier_post((unsigned*)(F.ctl + CW_BAR), F.MISC + 8);
    bar.wv = F.wave;
    int bid = (int)blockIdx.x;
#define RELAUNDER() do { int t_ = wave0_ * 64 + LANE_ID(); asm volatile("" : "+v"(t_)); F.tid = t_; F.lane = t_ & 63; F.wave = wave0_; \
    int b_ = blockIdx.x; asm volatile("" : "+s"(b_)); bid = b_; F.vcu = (F.G % 8 == 0) ? (b_ % 8) * (F.G / 8) + b_ / 8 : b_; } while (0)
#define GRID_BAR() do { XcdBarrier bb_ = bar; asm volatile("" : "+s"(bb_.x)); xcd_barrier(bb_); RELAUNDER(); } while (0)

#ifndef NO_P0
    p0_prologue(F, args);
    float* SSb = (float*)(ws + WS_SS);
    x0_phase(F, args.in[0], ((bf16*)(F.ws + WS_X2)), SSb);
#endif
    GRID_BAR();
    for (int l = 0; l < NL; ++l) {
        { pg8::Gemm g{((bf16*)(F.ws + WS_X2)), (const bf16*)(ws + WS_WI) + (size_t)l * PINP * D, M, PINP, D, D}; pg8::StaticOrder S; S.init(M, PINP, F.G, bid);
          pg8::EpiInProj E{((bf16*)(F.ws + WS_PR)), PINP, args.in[3] + l * 32, args.in[4] + l * 32, SSb + (size_t)(2 * l) * M * 16};
          pg8::gemm_phase<pg8::EpiInProj, pg8::StaticOrder, true, true>(F.lds + RING_OFF, g, S, E, F.wave); }
        GRID_BAR();
        prep_scalars(F, args, l);
        GRID_BAR();
        scan_phase(F, args, l);
        { XcdBarrier bb_ = bar; asm volatile("" : "+s"(bb_.x)); xcd_split_arrive(bb_, (unsigned*)(F.ctl + CW_SBAR), (unsigned)l); RELAUNDER(); }
        attn_phase(F, args, l, (char*)lds + RING_OFF);
        if (bid < 96) { { XcdBarrier bb_ = bar; asm volatile("" : "+s"(bb_.x)); xcd_split_wait(bb_, (unsigned*)(F.ctl + CW_SBAR), (unsigned)l); RELAUNDER(); }
            carry_phase(F); }
        GRID_BAR();
#ifndef NO_FI
        finalize_phase(F, args, l);
#endif
        GRID_BAR();
        { pg8::Gemm g{((bf16*)(F.ws + WS_PR)) + SC0, (const bf16*)(ws + WS_WO) + (size_t)l * D * D, M, D, D, PINP}; pg8::StaticOrder S; S.init(M, D, F.G, bid);
          pg8::EpiResidB<false> E{((bf16*)(F.ws + WS_X2)), F.out, SSb + (size_t)(2 * l + 1) * M * 16, D};
          pg8::gemm_phase<pg8::EpiResidB<false>, pg8::StaticOrder, true, true>(F.lds + RING_OFF, g, S, E, F.wave); }
        GRID_BAR();
        { pg8::Gemm g{((bf16*)(F.ws + WS_X2)), (const bf16*)(ws + WS_WU) + (size_t)l * FF * D, M, FF, D, D}; pg8::StaticOrder S; S.init(M, FF, F.G, bid);
          pg8::EpiStoreBf16<1> E{((bf16*)(F.ws + WS_H)), FF, SSb + (size_t)(2 * l + 1) * M * 16};
          pg8::gemm_phase<pg8::EpiStoreBf16<1>, pg8::StaticOrder, true, true>(F.lds + RING_OFF, g, S, E, F.wave); }
        GRID_BAR();
        { pg8::Gemm g{((bf16*)(F.ws + WS_H)), (const bf16*)(ws + WS_WD) + (size_t)l * D * FF, M, D, FF, FF}; pg8::StaticOrder S; S.init(M, D, F.G, bid);
          if (l < NL - 1) { pg8::EpiResidB<false> E{((bf16*)(F.ws + WS_X2)), F.out, SSb + (size_t)(2 * l + 2) * M * 16, D};
            pg8::gemm_phase<pg8::EpiResidB<false>, pg8::StaticOrder, true, true>(F.lds + RING_OFF, g, S, E, F.wave); }
          else { pg8::EpiResidB<true> E{((bf16*)(F.ws + WS_X2)), F.out, SSb, D};
            pg8::gemm_phase<pg8::EpiResidB<true>, pg8::StaticOrder, true, true>(F.lds + RING_OFF, g, S, E, F.wave); } }
        GRID_BAR();
    }
}

extern "C" void kernel_launch(void* const* d_in, const int* in_sizes, int n_in, void* d_out, int out_size, void* d_ws, size_t ws_size, hipStream_t stream) {
    static int grid = 0;
    if (grid == 0) {
        if (n_in != 30 || out_size != M * D || ws_size < WS_END) { fprintf(stderr, "kernel_launch: unexpected shapes (n_in %d, out %d, ws %zu < %zu)\n", n_in, out_size, ws_size, (size_t)WS_END); grid = -1; return; }
        int dev = 0, cus = 0, per_cu = 0;
        if (hipGetDevice(&dev) != hipSuccess || hipDeviceGetAttribute(&cus, hipDeviceAttributeMultiprocessorCount, dev) != hipSuccess) { grid = -1; return; }
        if (hipFuncSetAttribute((const void*)fwd_kernel, hipFuncAttributeMaxDynamicSharedMemorySize, LDS_BYTES) != hipSuccess) { fprintf(stderr, "kernel_launch: hipFuncSetAttribute failed\n"); grid = -1; return; }
        if (hipOccupancyMaxActiveBlocksPerMultiprocessor(&per_cu, (const void*)fwd_kernel, NWAVES * 64, LDS_BYTES) != hipSuccess || per_cu < 1)
            fprintf(stderr, "kernel_launch: occupancy query reports %d blocks per CU\n", per_cu);
        (void)hipGetLastError();
        grid = cus;
    }
    if (grid < 0) return;
    if (hipMemsetAsync((char*)d_ws + WS_CTL, 0, CTL_ZERO_BYTES, stream) != hipSuccess) return;
    Args a{};
    for (int i = 0; i < 30; ++i) a.in[i] = (const float*)d_in[i];
    a.out = (float*)d_out; a.ws = (unsigned char*)d_ws;
    hipLaunchKernelGGL(fwd_kernel, dim3(grid), dim3(NWAVES * 64), LDS_BYTES, stream, a);
}
```
